# Optimizing an MI355X kernel written in HIP

```python
import math
import jax, jax.numpy as jnp
from jax import lax
import numpy as np

D_MODEL = 2048
BATCH = 2
SEQ = 4096
DEPTH = 2

CHUNK = 64
Q_BLOCK = 128
EPS = 1e-6

SB_HEADS = 4
SB_HEAD_DIM = 128
SB_WIDTH = SB_HEADS * SB_HEAD_DIM

MLA_HEADS = 8
MLA_NOPE = 128
MLA_ROPE = 64
MLA_QK = MLA_NOPE + MLA_ROPE
MLA_V = 128
MLA_WIDTH = MLA_HEADS * MLA_V
Q_LORA = 512
KV_LORA = 512
ROPE_THETA = 10000.0

RW_HEADS = 8
RW_HEAD_DIM = 64
RW_WIDTH = RW_HEADS * RW_HEAD_DIM
DECAY_LORA = 64
ICL_LORA = 64
RW_GN_EPS = 64e-5
RW_SHIFT_WIDTH = 3 * RW_WIDTH + DECAY_LORA + ICL_LORA

N_BRANCH = 3
SB_COLS = 4 * SB_WIDTH
MLA_COLS = Q_LORA + KV_LORA + MLA_ROPE + MLA_WIDTH
RW_COLS = RW_SHIFT_WIDTH + RW_WIDTH
GATE_COLS = N_BRANCH * D_MODEL
N_IN = SB_COLS + MLA_COLS + RW_COLS + GATE_COLS

kernel_name = "hybrid_sb_mla_rwkv7_gated_merge"


def rms_norm(x, g, eps=EPS):
    xf = x.astype(jnp.float32)
    y = xf * lax.rsqrt(jnp.mean(xf * xf, axis=-1, keepdims=True) + eps)
    return (y * g.astype(jnp.float32)).astype(x.dtype)


def split_cols(t, sizes):
    out, start = [], 0
    for n in sizes:
        out.append(t[..., start:start + n])
        start += n
    return out


def rope(x, pos):
    half = x.shape[-1] // 2
    freqs = ROPE_THETA ** (-jnp.arange(half, dtype=jnp.float32) / half)
    ang = pos.astype(jnp.float32)[:, None] * freqs[None, :]
    cos = jnp.cos(ang)[None, :, None, :]
    sin = jnp.sin(ang)[None, :, None, :]
    x1, x2 = x[..., :half], x[..., half:]
    return jnp.concatenate([x1 * cos - x2 * sin, x1 * sin + x2 * cos], axis=-1).astype(x.dtype)


def stick_breaking_attention(q, k, v):
    S, Dh = q.shape[1], q.shape[-1]
    scale = Dh ** -0.5
    outs = []
    for i in range(S // Q_BLOCK):
        q0, q1 = i * Q_BLOCK, (i + 1) * Q_BLOCK
        z = jnp.einsum('bqhd,bkhd->bhqk', q[:, q0:q1], k[:, :q1]).astype(jnp.float32) * scale
        t_pos = q0 + jnp.arange(Q_BLOCK)
        s_pos = jnp.arange(q1)
        causal = s_pos[None, :] < t_pos[:, None]
        log_beta = jax.nn.log_sigmoid(z)
        log_fail = jnp.where(causal, log_beta - z, 0.0)
        between = lax.cumsum(log_fail, axis=3, reverse=True) - log_fail
        w = jnp.where(causal, jnp.exp(log_beta + between), 0.0)
        outs.append(jnp.einsum('bhqk,bkhd->bqhd', w.astype(v.dtype), v[:, :q1]))
    return jnp.concatenate(outs, axis=1)


def chunk_causal_softmax_attention(q, k, v):
    S, Dh = q.shape[1], q.shape[-1]
    scale = Dh ** -0.5
    outs = []
    for i in range(S // Q_BLOCK):
        q0, q1 = i * Q_BLOCK, (i + 1) * Q_BLOCK
        s = jnp.einsum('bqhd,bkhd->bhqk', q[:, q0:q1], k[:, :q1]).astype(jnp.float32) * scale
        t_chunk = (q0 + jnp.arange(Q_BLOCK)) // CHUNK
        s_chunk = jnp.arange(q1) // CHUNK
        mask = s_chunk[None, :] <= t_chunk[:, None]
        p = jax.nn.softmax(jnp.where(mask, s, -jnp.inf), axis=-1)
        outs.append(jnp.einsum('bhqk,bkhd->bqhd', p.astype(v.dtype), v[:, :q1]))
    return jnp.concatenate(outs, axis=1)


def rwkv7_scan(r, decay, k, v, a_vec, b_vec):
    B, S, H, N = r.shape

    def step(state, inp):
        r_t, w_t, k_t, v_t, a_t, b_t = inp
        sa = jnp.einsum('bhij,bhj->bhi', state, a_t)
        state = (state * w_t[:, :, None, :] + sa[..., None] * b_t[:, :, None, :]
                 + v_t[..., None] * k_t[:, :, None, :])
        return state, jnp.einsum('bhij,bhj->bhi', state, r_t)

    xs = tuple(jnp.moveaxis(t, 1, 0) for t in (r, decay, k, v, a_vec, b_vec))
    state0 = jnp.zeros((B, H, N, N), jnp.float32)
    _, out = lax.scan(step, state0, xs)
    return jnp.moveaxis(out, 0, 1)


def rwkv7_mixer(r, k, v, w_down, a_down, w0, w_up, a0, a_up, k_k, k_a, r_k, gn_g, gn_b):
    B, S, _ = r.shape
    dt = r.dtype
    f32 = jnp.float32
    heads = lambda t: t.astype(f32).reshape(B, S, RW_HEADS, RW_HEAD_DIM)
    w_log = -jax.nn.softplus(-(w0 + jnp.tanh(w_down) @ w_up).astype(f32)) - 0.5
    decay = jnp.exp(-jnp.exp(w_log))
    a = jax.nn.sigmoid((a0 + a_down @ a_up).astype(f32))
    kk = heads(k * k_k)
    kk = kk / jnp.maximum(jnp.sqrt(jnp.sum(kk * kk, axis=-1, keepdims=True)), 1e-12)
    k_mod = k.astype(f32) * (1.0 + (a - 1.0) * k_a.astype(f32))
    rh, kh, vh, ah = heads(r), heads(k_mod), heads(v), heads(a)
    o = rwkv7_scan(rh, heads(decay), kh, vh, -kk, kk * ah)
    mu = jnp.mean(o, axis=-1, keepdims=True)
    var = jnp.mean(jnp.square(o - mu), axis=-1, keepdims=True)
    o = ((o - mu) * lax.rsqrt(var + RW_GN_EPS)).reshape(B, S, RW_WIDTH)
    o = o * gn_g.astype(f32) + gn_b.astype(f32)
    bonus = jnp.sum(rh * kh * r_k.astype(f32), axis=-1, keepdims=True) * vh
    return (o + bonus.reshape(B, S, RW_WIDTH)).astype(dt)


def setup_inputs(seed: int = 0) -> dict:
    key = jax.random.key(seed)
    ks = iter(jax.random.split(key, 32))
    L = DEPTH
    nrm = lambda shape, scale: jax.random.normal(next(ks), shape, jnp.float32) * scale
    gain = lambda shape: 1.0 + 0.1 * jax.random.normal(next(ks), shape, jnp.float32)
    return {
        "x": nrm((BATCH, SEQ, D_MODEL), 1.0),
        "norm_g": gain((L, D_MODEL)),
        "w_in": nrm((L, D_MODEL, N_IN), D_MODEL ** -0.5),
        "mla_q_norm_g": gain((L, Q_LORA)),
        "mla_kv_norm_g": gain((L, KV_LORA)),
        "mla_w_uq": nrm((L, Q_LORA, MLA_HEADS * MLA_QK), Q_LORA ** -0.5),
        "mla_w_ukv": nrm((L, KV_LORA, MLA_HEADS * (MLA_NOPE + MLA_V)), KV_LORA ** -0.5),
        "mla_qn_g": gain((L, MLA_QK)),
        "mla_kn_g": gain((L, MLA_QK)),
        "rw_mu": jax.random.uniform(next(ks), (L, RW_SHIFT_WIDTH), jnp.float32),
        "rw_w0": jax.random.uniform(next(ks), (L, RW_WIDTH), jnp.float32, minval=-6.0, maxval=-1.0),
        "rw_w_up": nrm((L, DECAY_LORA, RW_WIDTH), 0.5 * DECAY_LORA ** -0.5),
        "rw_a0": nrm((L, RW_WIDTH), 0.5),
        "rw_a_up": nrm((L, ICL_LORA, RW_WIDTH), ICL_LORA ** -0.5),
        "rw_k_k": 0.85 + 0.05 * jax.random.normal(next(ks), (L, RW_WIDTH), jnp.float32),
        "rw_k_a": 1.0 + 0.05 * jax.random.normal(next(ks), (L, RW_WIDTH), jnp.float32),
        "rw_r_k": nrm((L, RW_HEADS, RW_HEAD_DIM), 0.1),
        "rw_gn_g": gain((L, RW_WIDTH)),
        "rw_gn_b": nrm((L, RW_WIDTH), 0.02),
        "w_br_sb": nrm((L, SB_WIDTH, D_MODEL), SB_WIDTH ** -0.5),
        "w_br_mla": nrm((L, MLA_WIDTH, D_MODEL), MLA_WIDTH ** -0.5),
        "w_br_rw": nrm((L, RW_WIDTH, D_MODEL), RW_WIDTH ** -0.5),
        "w_out": nrm((L, D_MODEL, D_MODEL), D_MODEL ** -0.5),
    }


def reference(x, norm_g, w_in, mla_q_norm_g, mla_kv_norm_g, mla_w_uq, mla_w_ukv, mla_qn_g, mla_kn_g,
              rw_mu, rw_w0, rw_w_up, rw_a0, rw_a_up, rw_k_k, rw_k_a, rw_r_k, rw_gn_g, rw_gn_b,
              w_br_sb, w_br_mla, w_br_rw, w_out):
    B, S, _ = x.shape
    pos = jnp.arange(S)
    for l in range(DEPTH):
        h = rms_norm(x, norm_g[l])
        p = h @ w_in[l]
        p_sb, p_mla, p_rw, p_gate = split_cols(p, (SB_COLS, MLA_COLS, RW_COLS, GATE_COLS))

        sq, sk, sv, sg = split_cols(p_sb, (SB_WIDTH,) * 4)
        sbh = lambda t: t.reshape(B, S, SB_HEADS, SB_HEAD_DIM)
        y_sb = stick_breaking_attention(sbh(sq), sbh(sk), sbh(sv)).reshape(B, S, SB_WIDTH)
        y_sb = y_sb * jax.nn.silu(sg)

        c_q, c_kv, k_rope, mg = split_cols(p_mla, (Q_LORA, KV_LORA, MLA_ROPE, MLA_WIDTH))
        q = (rms_norm(c_q, mla_q_norm_g[l]) @ mla_w_uq[l]).reshape(B, S, MLA_HEADS, MLA_QK)
        kv = (rms_norm(c_kv, mla_kv_norm_g[l]) @ mla_w_ukv[l]).reshape(B, S, MLA_HEADS, MLA_NOPE + MLA_V)
        k_nope, v_m = kv[..., :MLA_NOPE], kv[..., MLA_NOPE:]
        k = jnp.concatenate(
            [k_nope, jnp.broadcast_to(k_rope[:, :, None, :], (B, S, MLA_HEADS, MLA_ROPE))], axis=-1)
        q = rms_norm(q, mla_qn_g[l])
        k = rms_norm(k, mla_kn_g[l])
        q = jnp.concatenate([q[..., :MLA_NOPE], rope(q[..., MLA_NOPE:], pos)], axis=-1)
        k = jnp.concatenate([k[..., :MLA_NOPE], rope(k[..., MLA_NOPE:], pos)], axis=-1)
        y_mla = chunk_causal_softmax_attention(q, k, v_m).reshape(B, S, MLA_WIDTH)
        y_mla = y_mla * jax.nn.silu(mg)

        rw_main, rg = split_cols(p_rw, (RW_SHIFT_WIDTH, RW_WIDTH))
        prev = jnp.pad(rw_main, ((0, 0), (1, 0), (0, 0)))[:, :-1]
        rw_main = rw_main + rw_mu[l] * (prev - rw_main)
        rr, rk, rv, wd, ad = split_cols(rw_main, (RW_WIDTH,) * 3 + (DECAY_LORA, ICL_LORA))
        y_rw = rwkv7_mixer(rr, rk, rv, wd, ad, rw_w0[l], rw_w_up[l], rw_a0[l], rw_a_up[l],
                           rw_k_k[l], rw_k_a[l], rw_r_k[l], rw_gn_g[l], rw_gn_b[l])
        y_rw = y_rw * jax.nn.silu(rg)

        g_sb, g_mla, g_rw = split_cols(jax.nn.sigmoid(p_gate), (D_MODEL,) * N_BRANCH)
        merged = (g_sb * (y_sb @ w_br_sb[l]) + g_mla * (y_mla @ w_br_mla[l])
                  + g_rw * (y_rw @ w_br_rw[l]))
        x = x + merged @ w_out[l]
    return x
```

```cpp
#include <hip/hip_runtime.h>
#include <hip/hip_cooperative_groups.h>
#include <cstdio>
#include <cstdint>
namespace cg = cooperative_groups;

#define LAS __attribute__((address_space(3)))
typedef unsigned short bf16_t;
typedef short bf16x8 __attribute__((ext_vector_type(8)));
typedef short s16x4 __attribute__((ext_vector_type(4)));
typedef float f32x2 __attribute__((ext_vector_type(2)));
typedef float f32x4 __attribute__((ext_vector_type(4)));
typedef float f32x16 __attribute__((ext_vector_type(16)));
typedef unsigned u32x4 __attribute__((ext_vector_type(4)));
typedef unsigned u32x2 __attribute__((ext_vector_type(2)));

constexpr int T = 8192, S = 4096, DM = 2048, NP = 12800;
constexpr int PRW_LD = 1792;
constexpr int PC_SBQ = 0, PC_SBK = 512, PC_SBV = 1024, PC_SBG = 1536, PC_CQ = 2048, PC_CKV = 2560, PC_KR = 3072, PC_MG = 3328,
              PC_RG = 6144, PC_GATE = 6656;
constexpr float EPS = 1e-6f;
constexpr float CQ_MLA = 0.10411754627697264f;
constexpr float SCALE_SB = 0.08838834764831845f;

constexpr size_t MiB = 1u << 20;
constexpr size_t WS_CTL = 0, WS_ROPE = 1 * MiB, WS_WIN = 2 * MiB, WS_WUQ = 102 * MiB, WS_WUKV = 106 * MiB, WS_WBR = 110 * MiB, WS_WOUT = 126 * MiB,
                 WS_XB = 142 * MiB, WS_P = 174 * MiB, WS_PRW = 374 * MiB, WS_QF = 430 * MiB, WS_KF = 454 * MiB, WS_VF = 478 * MiB, WS_SCN = 494 * MiB,
                 WS_OSC = 590 * MiB, WS_YCAT = 606 * MiB, WS_MRG32 = 638 * MiB, WS_MRGB = 702 * MiB, WS_END = 734 * MiB;
constexpr int CTL_SSQX = 0, CTL_SSQCQ = 2 * T, CTL_SSQCKV = 4 * T, CTL_SSQKR = 6 * T, CTL_QUEUE = 131072;

constexpr int LDS_RING = 131072, LDS_SCR = 131072, LDS_BYTES = 147456;

__device__ __forceinline__ unsigned f2bf(float f) { unsigned u = __builtin_bit_cast(unsigned, f); return (u + 0x7fffu + ((u >> 16) & 1u)) >> 16; }
__device__ __forceinline__ unsigned pk2(float lo, float hi) { return f2bf(lo) | (f2bf(hi) << 16); }
__device__ __forceinline__ unsigned cvtpk(float lo, float hi) { unsigned r; asm volatile("v_cvt_pk_bf16_f32 %0, %1, %2" : "=v"(r) : "v"(lo), "v"(hi)); return r; }
__device__ __forceinline__ float bf2f(unsigned short b) { return __builtin_bit_cast(float, (unsigned)b << 16); }
__device__ __forceinline__ float bflo(unsigned w) { return __builtin_bit_cast(float, w << 16); }
__device__ __forceinline__ float bfhi(unsigned w) { return __builtin_bit_cast(float, w & 0xffff0000u); }
__device__ __forceinline__ float wave_sum(float v) {
#pragma unroll
    for (int o = 1; o < 64; o <<= 1) v += __shfl_xor(v, o);
    return v;
}
__device__ __forceinline__ float fsigmoid(float x) { return __builtin_amdgcn_rcpf(1.f + __expf(-x)); }
__device__ __forceinline__ float fsilu(float x) { return x * fsigmoid(x); }
#define LDS_WAIT() asm volatile("s_waitcnt lgkmcnt(0)" ::: "memory")

namespace pg8 {
constexpr int BM = 256, BK = 64, HALF = 128, HTB = HALF * BK * 2;
__device__ __forceinline__ int lds_byte(int r, int c) { const int st = (r >> 4) * 2 + (c >> 5), rr = r & 15, cc = c & 31, ob = rr * 64 + cc * 2; return st * 1024 + (ob ^ (((ob >> 9) & 1) << 5)); }
__device__ __forceinline__ void stage_rc(int b, int& R, int& C) { const int st = b / 1024, sb = b % 1024, swz = sb ^ (((sb >> 9) & 1) << 5); R = (st >> 1) * 16 + swz / 64; C = (st & 1) * 32 + (swz % 64) / 2; }
__device__ __forceinline__ int perm32(int rho) { const int n = rho >> 4, i = rho & 15; return 8 * (i >> 2) + 4 * n + (i & 3); }

struct GUnit { const char* A; const char* B; int nt, pm, pn, aux; };

template <class Epi, class Sched>
__device__ __forceinline__ void gemm_phase(LAS unsigned char* lds, const int lda, const int ldb, const Sched& S, const Epi& E) {
    int tid = threadIdx.x; asm volatile("" : "+v"(tid));
    const int wid = __builtin_amdgcn_readfirstlane(tid >> 6), lane = tid & 63, wr = wid >> 2, wc = wid & 3, fr = lane & 15, fq = lane >> 4;
    unsigned voffA[2], voffB[2];
#pragma unroll
    for (int i = 0; i < 2; ++i) { int R, C; stage_rc(tid * 16 + i * 8192, R, C); const int Rb = (R & ~31) + perm32(R & 31);
        voffA[i] = (unsigned)(R * lda + C) * 2u; voffB[i] = (unsigned)(Rb * ldb + C) * 2u; }
    const size_t kstep = (size_t)(BK * 2);
    const size_t hstepA = (size_t)HALF * lda * 2, hstepB = (size_t)HALF * ldb * 2;
    const unsigned ldsw = (unsigned)wid * 1024u;
    const int aoff = lds_byte(wr * 64 + fr, fq * 8), boff = lds_byte(wc * 32 + fr, fq * 8);
#define PG8_SA(b, h) (((b) * 2 + (h)) * HTB)
#define PG8_SB(b, h) ((4 + (b) * 2 + (h)) * HTB)
#define PG8_STAGE(bufoff, gbase, voff) do { _Pragma("unroll") for (int _i = 0; _i < 2; ++_i) \
        __builtin_amdgcn_global_load_lds((const unsigned*)((const char*)(gbase) + (voff)[_i]), (LAS unsigned*)(lds + (bufoff) + ldsw + _i * 8192), 16, 0, 0); } while (0)
#define PG8_LDA(dst, b, h) do { _Pragma("unroll") for (int m = 0; m < 4; ++m) _Pragma("unroll") for (int k = 0; k < 2; ++k) dst[m][k] = *(const LAS bf16x8*)(lds + PG8_SA(b, h) + aoff + m * 2048 + k * 1024); } while (0)
#define PG8_LDB(dst, b, h) do { _Pragma("unroll") for (int n = 0; n < 2; ++n) _Pragma("unroll") for (int k = 0; k < 2; ++k) dst[n][k] = *(const LAS bf16x8*)(lds + PG8_SB(b, h) + boff + n * 2048 + k * 1024); } while (0)
#define PG8_MMA(ai, bj, At, Bt) do { __builtin_amdgcn_s_setprio(1); _Pragma("unroll") for (int m = 0; m < 4; ++m) _Pragma("unroll") for (int n = 0; n < 2; ++n) _Pragma("unroll") for (int k = 0; k < 2; ++k) \
        acc[ai][bj][m][n] = __builtin_amdgcn_mfma_f32_16x16x32_bf16(Bt[n][k], At[m][k], acc[ai][bj][m][n], 0, 0, 0); __builtin_amdgcn_s_setprio(0); } while (0)
#define PG8_WAIT_V(n) asm volatile("s_waitcnt vmcnt(" #n ")" ::: "memory")
#define PG8_WAIT_L(n) asm volatile("s_waitcnt lgkmcnt(" #n ")" ::: "memory")
#define PG8_BAR __builtin_amdgcn_s_barrier()
#define PG8_SCHED __builtin_amdgcn_sched_barrier(0)
    GUnit cur, nxt; int ui = 0;
    if (!S.next(0, cur)) return;
    f32x4 acc[2][2][4][2];
#pragma unroll
    for (int a = 0; a < 2; ++a)
#pragma unroll
        for (int b = 0; b < 2; ++b)
#pragma unroll
            for (int m = 0; m < 4; ++m)
#pragma unroll
                for (int n = 0; n < 2; ++n) acc[a][b][m][n] = (f32x4){0.f, 0.f, 0.f, 0.f};
    bf16x8 At[4][2], B0[2][2], B1[2][2];
    const char* cA = cur.A; const char* cB = cur.B;
    PG8_STAGE(PG8_SB(0, 0), cB, voffB); PG8_STAGE(PG8_SB(0, 1), cB + hstepB, voffB); PG8_STAGE(PG8_SA(0, 0), cA, voffA); PG8_STAGE(PG8_SA(0, 1), cA + hstepA, voffA);
    if (wr == 1) PG8_BAR;
    PG8_WAIT_V(2); PG8_BAR;
    PG8_STAGE(PG8_SB(1, 0), cB + kstep, voffB); PG8_STAGE(PG8_SA(1, 0), cA + kstep, voffA); PG8_STAGE(PG8_SB(1, 1), cB + hstepB + kstep, voffB);
    PG8_WAIT_V(6); PG8_BAR;
    for (;;) {
        const bool has_next = S.next(ui + 1, nxt);
        const char* nA = has_next ? nxt.A : cA; const char* nB = has_next ? nxt.B : cB;
        const int nt = cur.nt;
        for (int t = 0; t < nt; t += 2) {
            if constexpr (Epi::HAS_MID) { if (t == 8 || t == 24) { int fr_ = fr, fq_ = fq; asm volatile("" : "+v"(fr_), "+v"(fq_)); E.mid(acc, cur, t, wr, wc, fr_, fq_); } }
            const bool last = (t == nt - 2);
            const char* a1 = cA + (size_t)(t + 1) * kstep;
            const char* a2 = last ? nA : cA + (size_t)(t + 2) * kstep; const char* b2 = last ? nB : cB + (size_t)(t + 2) * kstep;
            const char* a3 = a2 + kstep; const char* b3 = b2 + kstep;
            PG8_LDB(B0, 0, 0); PG8_LDB(B1, 0, 1); PG8_SCHED; PG8_LDA(At, 0, 0); PG8_STAGE(PG8_SA(1, 1), a1 + hstepA, voffA);
            PG8_WAIT_V(8); PG8_WAIT_L(0); PG8_BAR; PG8_MMA(0, 0, At, B0); PG8_MMA(0, 1, At, B1); PG8_BAR; PG8_SCHED;
            PG8_LDA(At, 0, 1); PG8_STAGE(PG8_SB(0, 0), b2, voffB); PG8_STAGE(PG8_SB(0, 1), b2 + hstepB, voffB); PG8_STAGE(PG8_SA(0, 0), a2, voffA);
            PG8_WAIT_V(8); PG8_WAIT_L(0); PG8_BAR; PG8_MMA(1, 0, At, B0); PG8_MMA(1, 1, At, B1); PG8_BAR; PG8_SCHED;
            PG8_LDB(B0, 1, 0); PG8_LDB(B1, 1, 1); PG8_SCHED; PG8_LDA(At, 1, 0); PG8_STAGE(PG8_SA(0, 1), a2 + hstepA, voffA);
            PG8_WAIT_V(8); PG8_WAIT_L(0); PG8_BAR; PG8_MMA(0, 0, At, B0); PG8_MMA(0, 1, At, B1); PG8_BAR; PG8_SCHED;
            PG8_LDA(At, 1, 1); PG8_STAGE(PG8_SB(1, 0), b3, voffB); PG8_STAGE(PG8_SB(1, 1), b3 + hstepB, voffB); PG8_STAGE(PG8_SA(1, 0), a3, voffA);
            PG8_WAIT_V(8); PG8_WAIT_L(0); PG8_BAR; PG8_MMA(1, 0, At, B0); PG8_MMA(1, 1, At, B1); PG8_BAR; PG8_SCHED;
        }
        if (wr == 0) PG8_BAR;
        { GUnit eu = cur; eu.pm = __builtin_amdgcn_readfirstlane(cur.pm); eu.pn = __builtin_amdgcn_readfirstlane(cur.pn); eu.aux = __builtin_amdgcn_readfirstlane(cur.aux);
          int wr_ = wr, wc_ = wc, fr_ = fr, fq_ = fq;
          asm volatile("" : "+s"(eu.pm), "+s"(eu.pn), "+s"(eu.aux), "+s"(wr_), "+s"(wc_), "+v"(fr_), "+v"(fq_));
          E(acc, eu, wr_, wc_, fr_, fq_); }
        if (!has_next) break;
#pragma unroll
        for (int a = 0; a < 2; ++a)
#pragma unroll
            for (int b = 0; b < 2; ++b)
#pragma unroll
                for (int m = 0; m < 4; ++m)
#pragma unroll
                    for (int n = 0; n < 2; ++n) acc[a][b][m][n] = (f32x4){0.f, 0.f, 0.f, 0.f};
        cur = nxt; cA = nA; cB = nB; ++ui;
        if (wr == 1) PG8_BAR;
    }
    PG8_WAIT_V(0);
    PG8_BAR;
#undef PG8_SA
#undef PG8_SB
#undef PG8_STAGE
#undef PG8_LDA
#undef PG8_LDB
#undef PG8_MMA
#undef PG8_WAIT_V
#undef PG8_WAIT_L
#undef PG8_SCHED
}
}
using pg8::GUnit;

#define XB_TMO      128
#define XB_XCNT(j)  (256  + 64 * (j))
#define XB_XSUB(j)  (1280 + 64 * (j))
#define XB_XGEN(j)  (2304 + 64 * (j))
#define XB_TOP      3328
#define XB_TOPGEN   3392
#define XCD_BAR_WORDS 3456
#define XB_SPIN_CAP (1u << 18)

__device__ __forceinline__ unsigned xb_ld(unsigned* p)              { return __hip_atomic_load(p, __ATOMIC_RELAXED, __HIP_MEMORY_SCOPE_AGENT); }
__device__ __forceinline__ unsigned xb_add(unsigned* p, unsigned v) { return __hip_atomic_fetch_add(p, v, __ATOMIC_RELAXED, __HIP_MEMORY_SCOPE_AGENT); }
__device__ __forceinline__ unsigned xb_xcc_id() { return (unsigned)__builtin_amdgcn_s_getreg((3 << 11) | 20) & 0xFu; }
#define XB_SPIN(cond, bar) do { unsigned _sp = 0; while (cond) { __builtin_amdgcn_s_sleep(1); \
    if ((++_sp & 255u) == 0u) { if (xb_ld(&(bar)[XB_TMO])) break; if (_sp > XB_SPIN_CAP) { atomicAdd(&(bar)[XB_TMO], 1u); break; } } } } while (0)

struct XcdBarrier {
    unsigned* bar; unsigned x;
    volatile LAS unsigned* st;
};

__device__ __forceinline__ XcdBarrier xcd_barrier_post(unsigned* bar, volatile LAS unsigned* st) {
    XcdBarrier b; b.bar = bar; b.x = xb_xcc_id(); b.st = st;
    if (threadIdx.x == 0) (void)xb_add(&bar[XB_XCNT(b.x)], 1u);
    return b;
}
__device__ __forceinline__ void xcd_barrier_complete(unsigned* bar, unsigned x, unsigned& nloc, unsigned& nx) {
    const unsigned G = gridDim.x * gridDim.y * gridDim.z;
    unsigned sum, cnt, mine, sp = 0u;
    for (;;) {
        sum = 0u; cnt = 0u; mine = 0u;
#pragma unroll
        for (unsigned j = 0; j < 16; ++j) { const unsigned c = xb_ld(&bar[XB_XCNT(j)]); sum += c; cnt += (c > 0u) ? 1u : 0u; mine = (j == x) ? c : mine; }
        if (sum == G) break;
        __builtin_amdgcn_s_sleep(1);
        if ((++sp & 255u) == 0u) { if (xb_ld(&bar[XB_TMO])) break; if (sp > XB_SPIN_CAP) { atomicAdd(&bar[XB_TMO], 1u); break; } }
    }
    nloc = mine > 0u ? mine : 1u; nx = cnt > 0u ? cnt : 1u;
}

__device__ __forceinline__ void xcd_barrier(const XcdBarrier& b) {
    asm volatile("s_waitcnt vmcnt(0)" ::: "memory");
    __syncthreads();
    if (threadIdx.x == 0) {
        unsigned* bar = b.bar;
        __builtin_amdgcn_s_waitcnt(0);
        unsigned nloc = b.st[0], nx = b.st[1];
        if (nloc == 0u) { xcd_barrier_complete(bar, b.x, nloc, nx); b.st[0] = nloc; b.st[1] = nx; }
        const unsigned old = xb_add(&bar[XB_XSUB(b.x)], 1u);
        const unsigned gen = old / nloc;
        if (old + 1u == (gen + 1u) * nloc) {
            __builtin_amdgcn_fence(__ATOMIC_RELEASE, "agent");
            asm volatile("s_waitcnt vmcnt(0)" ::: "memory");
            const unsigned og = xb_add(&bar[XB_TOP], 1u);
            const unsigned tg = og / nx;
            if (og + 1u == (tg + 1u) * nx) xb_add(&bar[XB_TOPGEN], 1u);
            else XB_SPIN(xb_ld(&bar[XB_TOPGEN]) == tg, bar);
            __builtin_amdgcn_fence(__ATOMIC_ACQUIRE, "agent");
            xb_add(&bar[XB_XGEN(b.x)], 1u);
            asm volatile("s_waitcnt vmcnt(0)" ::: "memory");
        } else {
            XB_SPIN(xb_ld(&bar[XB_XGEN(b.x)]) == gen, bar);
            __builtin_amdgcn_fence(__ATOMIC_ACQUIRE, "agent");
            asm volatile("s_waitcnt vmcnt(0)" ::: "memory");
        }
    }
    __syncthreads();
}


__device__ __forceinline__ void grid_bar(unsigned* cnt, unsigned target) {
    asm volatile("s_waitcnt vmcnt(0) lgkmcnt(0)" ::: "memory");
    __syncthreads();
    if (threadIdx.x == 0) {
        __builtin_amdgcn_fence(__ATOMIC_RELEASE, "agent");
        asm volatile("s_waitcnt vmcnt(0)" ::: "memory");
        __hip_atomic_fetch_add(cnt, 1u, __ATOMIC_RELAXED, __HIP_MEMORY_SCOPE_AGENT);
        while (__hip_atomic_load(cnt, __ATOMIC_RELAXED, __HIP_MEMORY_SCOPE_AGENT) < target) __builtin_amdgcn_s_sleep(1);
        __builtin_amdgcn_fence(__ATOMIC_ACQUIRE, "agent");
        asm volatile("s_waitcnt vmcnt(0)" ::: "memory");
    }
    __syncthreads();
}

__device__ __forceinline__ int vblock(int c, int G) { return (G % 8 == 0) ? (c % 8) * (G / 8) + c / 8 : c; }

struct SchedA {
    const char* A; const char* B; int G, c;
    __device__ __forceinline__ bool next(int i, GUnit& u) const {
        constexpr int nM = 32, nN = 50, nwg = nM * nN, NXCD = 8, WGM = 8;
        const long L = (long)i * G + c; if (L >= nwg) return false;
        int wgid = (int)L; { const int q = nwg / NXCD, r = nwg % NXCD, xcd = wgid % NXCD, off = wgid / NXCD; wgid = (xcd < r ? xcd * (q + 1) : r * (q + 1) + (xcd - r) * q) + off; }
        const int nig = WGM * nN, gid = wgid / nig, fm = gid * WGM, gsz = (nM - fm) < WGM ? (nM - fm) : WGM;
        u.pm = fm + ((wgid % nig) % gsz); u.pn = (wgid % nig) / gsz; u.nt = 32; u.aux = 0;
        u.A = A + (size_t)u.pm * 256 * DM * 2; u.B = B + (size_t)u.pn * 256 * DM * 2; return true;
    }
};
struct SchedA2 {
    const char* A; const char* B; int first, stride, limit;
    __device__ __forceinline__ bool next(int i, GUnit& u) const {
        constexpr int nM = 32, nN = 43, nwg = nM * nN, NXCD = 8, WGM = 8;
        const int L = first + i * stride; if (L >= limit) return false;
        int wgid = L; { const int q = nwg / NXCD, r = nwg % NXCD, xcd = wgid % NXCD, off = wgid / NXCD; wgid = (xcd < r ? xcd * (q + 1) : r * (q + 1) + (xcd - r) * q) + off; }
        const int nig = WGM * nN, gid = wgid / nig, fm = gid * WGM, gsz = (nM - fm) < WGM ? (nM - fm) : WGM;
        u.pm = fm + ((wgid % nig) % gsz); const int pn = (wgid % nig) / gsz; u.pn = pn < 17 ? pn : pn + 7; u.nt = 32; u.aux = 0;
        u.A = A + (size_t)u.pm * 256 * DM * 2; u.B = B + (size_t)u.pn * 256 * DM * 2; return true;
    }
};
struct SchedA1 {
    const char* A; const char* B; int G, vc, extra;
    __device__ __forceinline__ bool next(int i, GUnit& u) const {
        const int L = i * G + vc; if (L >= 224 + extra) return false;
        if (L >= 224) { SchedA2 s2{A, B, 43 * 32 - 32 + (L - 224), 1 << 20, 43 * 32}; return s2.next(0, u); }
        u.pm = L / 7; u.pn = 17 + L % 7; u.nt = 32; u.aux = 0;
        u.A = A + (size_t)u.pm * 256 * DM * 2; u.B = B + (size_t)u.pn * 256 * DM * 2; return true;
    }
};
struct SchedB {
    const char* P; const char* Wq; const char* Wkv; int G, vc;
    __device__ __forceinline__ bool next(int i, GUnit& u) const {
        const int L = i * G + vc; if (L >= 512) return false;
        const int isq = (L < 256), l2 = L & 255; u.pm = l2 >> 3; u.pn = l2 & 7; u.nt = 8; u.aux = isq ? 0 : 1;
        u.A = P + ((size_t)u.pm * 256 * NP + (isq ? PC_CQ : PC_CKV)) * 2; u.B = (isq ? Wq : Wkv) + (size_t)u.pn * 256 * 512 * 2; return true;
    }
};
struct SchedD {
    const char* Y; const char* W; int G, vc;
    __device__ __forceinline__ bool next(int i, GUnit& u) const {
        const int tile = i * G + vc; if (tile >= 256) return false;
        u.pm = tile >> 3; u.pn = tile & 7; u.aux = 0; u.nt = 32;
        u.A = Y + (size_t)u.pm * 256 * DM * 2; u.B = W + (size_t)u.pn * 256 * DM * 2; return true;
    }
};
struct SchedE {
    const char* A; const char* B; int G, vc;
    __device__ __forceinline__ bool next(int i, GUnit& u) const {
        const int tile = i * G + vc; if (tile >= 256) return false;
        u.pm = tile >> 3; u.pn = tile & 7; u.aux = 0; u.nt = 32;
        u.A = A + (size_t)u.pm * 256 * DM * 2; u.B = B + (size_t)u.pn * 256 * DM * 2; return true;
    }
};

struct EpiA {
    static constexpr bool HAS_MID = false;
    bf16_t* P; float* PRW; const float* ssqx; float* ssq_cq; float* ssq_ckv; float* ssq_kr;
    __device__ __forceinline__ void operator()(const f32x4 (&acc)[2][2][4][2], const GUnit& u, int wr, int wc, int fr, int fq) const {
        const int pn = u.pn;
        const int kind = (pn < 6) ? 0 : (pn < 8) ? 1 : (pn < 13) ? 0 : (pn < 17) ? 1 : (pn < 24) ? 3 : (pn < 26) ? 1 : 2;
        float* ssq = (pn >= 8 && pn < 10) ? ssq_cq : (pn >= 10 && pn < 12) ? ssq_ckv : (pn == 12) ? ssq_kr : nullptr;
        const int row0 = u.pm * 256 + wr * 64 + fr;
        float rsv[2][4];
#pragma unroll
        for (int ai = 0; ai < 2; ++ai)
#pragma unroll
            for (int m = 0; m < 4; ++m) rsv[ai][m] = ssqx[row0 + ai * 128 + m * 16];
#pragma unroll
        for (int ai = 0; ai < 2; ++ai)
#pragma unroll
            for (int m = 0; m < 4; ++m) rsv[ai][m] = rsqrtf(rsv[ai][m] * (1.f / 2048.f) + EPS);
#pragma unroll
        for (int ai = 0; ai < 2; ++ai)
#pragma unroll
            for (int m = 0; m < 4; ++m) {
                const int row = row0 + ai * 128 + m * 16;
                const float rs = rsv[ai][m];
                float sq = 0.f;
#pragma unroll
                for (int bj = 0; bj < 2; ++bj) {
                    f32x4 v0 = acc[ai][bj][m][0] * rs, v1 = acc[ai][bj][m][1] * rs;
                    const int cl = bj * 128 + wc * 32 + 8 * fq;
                    if (kind == 3) {
                        float* o = PRW + (size_t)row * PRW_LD + (pn - 17) * 256 + cl;
                        *(f32x4*)o = v0; *(f32x4*)(o + 4) = v1;
                    } else {
                        if (ssq) sq += (v0[0] * v0[0] + v0[1] * v0[1]) + (v0[2] * v0[2] + v0[3] * v0[3]) + (v1[0] * v1[0] + v1[1] * v1[1]) + (v1[2] * v1[2] + v1[3] * v1[3]);
                        if (kind == 1) {
#pragma unroll
                            for (int e = 0; e < 4; ++e) { v0[e] = fsilu(v0[e]); v1[e] = fsilu(v1[e]); }
                        } else if (kind == 2) {
#pragma unroll
                            for (int e = 0; e < 4; ++e) { v0[e] = fsigmoid(v0[e]); v1[e] = fsigmoid(v1[e]); }
                        }
                        u32x4 w; w.x = cvtpk(v0[0], v0[1]); w.y = cvtpk(v0[2], v0[3]); w.z = cvtpk(v1[0], v1[1]); w.w = cvtpk(v1[2], v1[3]);
                        *(u32x4*)(P + (size_t)row * NP + pn * 256 + cl) = w;
                    }
                }
                if (ssq) { sq += __shfl_xor(sq, 16); sq += __shfl_xor(sq, 32); if (fq == 0) atomicAdd(ssq + row, sq); }
            }
    }
};

struct EpiB {
    static constexpr bool HAS_MID = false;
    bf16_t* Qf; bf16_t* Kf; bf16_t* Vf; const bf16_t* P; const float* ssq_cq; const float* ssq_ckv; const float* ssq_kr;
    const float* qn_g; const float* kn_g; const float* rope; LAS float* scr;
    __device__ __forceinline__ void operator()(const f32x4 (&acc)[2][2][4][2], const GUnit& u, int wr, int wc, int fr, int fq) const {
        const int h = u.pn; const bool isq = (u.aux == 0);
        const float* ssqA = isq ? ssq_cq : ssq_ckv;
        LAS float* part = scr; LAS float* rstdL = scr + 1024;
        const int row0 = u.pm * 256 + wr * 64 + fr;
        float sv[2][4], krv[2][4];
#pragma unroll
        for (int ai = 0; ai < 2; ++ai)
#pragma unroll
            for (int m = 0; m < 4; ++m) { const int row = row0 + ai * 128 + m * 16; sv[ai][m] = ssqA[row]; krv[ai][m] = isq ? 0.f : ssq_kr[row]; }
#pragma unroll
        for (int ai = 0; ai < 2; ++ai)
#pragma unroll
            for (int m = 0; m < 4; ++m) sv[ai][m] = rsqrtf(sv[ai][m] * (1.f / 512.f) + EPS);
#pragma unroll
        for (int ai = 0; ai < 2; ++ai)
#pragma unroll
            for (int m = 0; m < 4; ++m) {
                const float s = sv[ai][m];
                float sq = 0.f;
#pragma unroll
                for (int bj = 0; bj < 2; ++bj) {
                    if (!isq && bj == 1) continue;
                    const f32x4 v0 = acc[ai][bj][m][0] * s, v1 = acc[ai][bj][m][1] * s;
                    sq += (v0[0] * v0[0] + v0[1] * v0[1]) + (v0[2] * v0[2] + v0[3] * v0[3]) + (v1[0] * v1[0] + v1[1] * v1[1]) + (v1[2] * v1[2] + v1[3] * v1[3]);
                }
                sq += __shfl_xor(sq, 16); sq += __shfl_xor(sq, 32);
                if (fq == 0) part[(ai * 128 + wr * 64 + m * 16 + fr) * 4 + wc] = sq;
                __builtin_amdgcn_sched_barrier(0);
            }
        LDS_WAIT(); PG8_BAR;
        const float* gq = isq ? qn_g : kn_g;
        const int c0 = wc * 32 + 8 * fq;
        f32x4 g0 = *(const f32x4*)(gq + c0), g1 = *(const f32x4*)(gq + c0 + 4);
        const int j = 4 * wc + fq;
        f32x4 gr1 = (f32x4){0.f, 0.f, 0.f, 0.f}, gr2 = gr1;
        if (isq && wc < 2) { gr1 = *(const f32x4*)(qn_g + 128 + 4 * j); gr2 = *(const f32x4*)(qn_g + 160 + 4 * j); }
#pragma unroll
        for (int ai = 0; ai < 2; ++ai)
#pragma unroll
            for (int m = 0; m < 4; ++m) {
                const int rl = ai * 128 + wr * 64 + m * 16 + fr, row = u.pm * 256 + rl;
                const f32x4 pp = *(const LAS f32x4*)(part + rl * 4);
                float tot = (pp[0] + pp[1]) + (pp[2] + pp[3]);
                if (!isq) tot += krv[ai][m];
                const float rstd = rsqrtf(tot * (1.f / 192.f) + EPS);
                const float s = sv[ai][m];
                if (isq) {
                    const float f = s * rstd * CQ_MLA;
                    { const f32x4 v0 = acc[ai][0][m][0] * f * g0, v1 = acc[ai][0][m][1] * f * g1;
                      u32x4 w; w.x = cvtpk(v0[0], v0[1]); w.y = cvtpk(v0[2], v0[3]); w.z = cvtpk(v1[0], v1[1]); w.w = cvtpk(v1[2], v1[3]);
                      *(u32x4*)(Qf + (size_t)row * 1536 + h * 192 + c0) = w; }
                    if (wc < 2) {
                        const int pos = row & (S - 1);
                        const f32x4 cs = *(const f32x4*)(rope + pos * 32 + 4 * j), sn = *(const f32x4*)(rope + S * 32 + pos * 32 + 4 * j);
                        const f32x4 x1 = acc[ai][1][m][0] * f * gr1, x2 = acc[ai][1][m][1] * f * gr2;
                        const f32x4 y1 = x1 * cs - x2 * sn, y2 = x1 * sn + x2 * cs;
                        u32x4 w; w.x = cvtpk(y1[0], y1[1]); w.y = cvtpk(y1[2], y1[3]); w.z = cvtpk(y2[0], y2[1]); w.w = cvtpk(y2[2], y2[3]);
                        *(u32x4*)(Qf + (size_t)row * 1536 + h * 192 + 128 + 8 * j) = w;
                    }
                } else {
                    if (wc == 0 && fq == 0) rstdL[rl] = rstd;
                    const float f = s * rstd;
                    { const f32x4 v0 = acc[ai][0][m][0] * f * g0, v1 = acc[ai][0][m][1] * f * g1;
                      u32x4 w; w.x = cvtpk(v0[0], v0[1]); w.y = cvtpk(v0[2], v0[3]); w.z = cvtpk(v1[0], v1[1]); w.w = cvtpk(v1[2], v1[3]);
                      *(u32x4*)(Kf + (size_t)row * 1536 + h * 192 + c0) = w; }
                    { const f32x4 v0 = acc[ai][1][m][0] * s, v1 = acc[ai][1][m][1] * s;
                      u32x4 w; w.x = cvtpk(v0[0], v0[1]); w.y = cvtpk(v0[2], v0[3]); w.z = cvtpk(v1[0], v1[1]); w.w = cvtpk(v1[2], v1[3]);
                      *(u32x4*)(Vf + (size_t)row * 1024 + h * 128 + c0) = w; }
                }
                __builtin_amdgcn_sched_barrier(0);
            }
        if (!isq) {
            LDS_WAIT(); PG8_BAR;
            int tid = fr + 16 * fq + 64 * (wr * 4 + wc);
            const int rl = tid >> 1, jj0 = (tid & 1) * 4, row = u.pm * 256 + rl, pos = row & (S - 1);
            const float rstd = rstdL[rl];
            const bf16_t* kr = P + (size_t)row * NP + PC_KR;
#pragma unroll
            for (int jj = 0; jj < 4; ++jj) {
                const int j2 = jj0 + jj;
                const u32x2 a = *(const u32x2*)(kr + 4 * j2), b = *(const u32x2*)(kr + 32 + 4 * j2);
                const f32x4 ga = *(const f32x4*)(kn_g + 128 + 4 * j2), gb = *(const f32x4*)(kn_g + 160 + 4 * j2);
                const f32x4 cs = *(const f32x4*)(rope + pos * 32 + 4 * j2), sn = *(const f32x4*)(rope + S * 32 + pos * 32 + 4 * j2);
                const f32x4 x1 = (f32x4){bflo(a.x), bfhi(a.x), bflo(a.y), bfhi(a.y)} * rstd * ga, x2 = (f32x4){bflo(b.x), bfhi(b.x), bflo(b.y), bfhi(b.y)} * rstd * gb;
                const f32x4 y1 = x1 * cs - x2 * sn, y2 = x1 * sn + x2 * cs;
                u32x4 w; w.x = cvtpk(y1[0], y1[1]); w.y = cvtpk(y1[2], y1[3]); w.z = cvtpk(y2[0], y2[1]); w.w = cvtpk(y2[2], y2[3]);
                *(u32x4*)(Kf + (size_t)row * 1536 + h * 192 + 128 + 8 * j2) = w;
            }
        }
    }
};

struct EpiD {
    static constexpr bool HAS_MID = true;
    static constexpr float GMIN = 1e-5f;
    bf16_t* Mb; const bf16_t* P;
    __device__ __forceinline__ void mid(f32x4 (&acc)[2][2][4][2], const GUnit& u, int t, int wr, int wc, int fr, int fq) const {
        const int from = (t == 8) ? 0 : 1; const int row0 = u.pm * 256 + wr * 64 + fr;
        const int col0 = u.pn * 256 + wc * 32 + 8 * fq;
#pragma unroll
        for (int ai = 0; ai < 2; ++ai) {
            u32x4 ga[4][2], gb[4][2];
#pragma unroll
            for (int m = 0; m < 4; ++m)
#pragma unroll
                for (int bj = 0; bj < 2; ++bj) {
                    const bf16_t* gp = P + (size_t)(row0 + ai * 128 + m * 16) * NP + PC_GATE + from * 2048 + col0 + bj * 128;
                    ga[m][bj] = *(const u32x4*)gp; gb[m][bj] = *(const u32x4*)(gp + 2048);
                }
#pragma unroll
            for (int m = 0; m < 4; ++m)
#pragma unroll
                for (int bj = 0; bj < 2; ++bj) {
                    const u32x4 a_ = ga[m][bj], b_ = gb[m][bj];
                    f32x4 r0, r1;
                    r0[0] = fmaxf(bflo(a_.x), GMIN) * __builtin_amdgcn_rcpf(fmaxf(bflo(b_.x), GMIN)); r0[1] = fmaxf(bfhi(a_.x), GMIN) * __builtin_amdgcn_rcpf(fmaxf(bfhi(b_.x), GMIN));
                    r0[2] = fmaxf(bflo(a_.y), GMIN) * __builtin_amdgcn_rcpf(fmaxf(bflo(b_.y), GMIN)); r0[3] = fmaxf(bfhi(a_.y), GMIN) * __builtin_amdgcn_rcpf(fmaxf(bfhi(b_.y), GMIN));
                    r1[0] = fmaxf(bflo(a_.z), GMIN) * __builtin_amdgcn_rcpf(fmaxf(bflo(b_.z), GMIN)); r1[1] = fmaxf(bfhi(a_.z), GMIN) * __builtin_amdgcn_rcpf(fmaxf(bfhi(b_.z), GMIN));
                    r1[2] = fmaxf(bflo(a_.w), GMIN) * __builtin_amdgcn_rcpf(fmaxf(bflo(b_.w), GMIN)); r1[3] = fmaxf(bfhi(a_.w), GMIN) * __builtin_amdgcn_rcpf(fmaxf(bfhi(b_.w), GMIN));
                    acc[ai][bj][m][0] *= r0; acc[ai][bj][m][1] *= r1;
                }
            __builtin_amdgcn_sched_barrier(0);
        }
    }
    __device__ __forceinline__ void operator()(const f32x4 (&acc)[2][2][4][2], const GUnit& u, int wr, int wc, int fr, int fq) const {
        const int row0 = u.pm * 256 + wr * 64 + fr;
#pragma unroll
        for (int ai = 0; ai < 2; ++ai) {
            u32x4 gv[4][2];
#pragma unroll
            for (int m = 0; m < 4; ++m)
#pragma unroll
                for (int bj = 0; bj < 2; ++bj) gv[m][bj] = *(const u32x4*)(P + (size_t)(row0 + ai * 128 + m * 16) * NP + PC_GATE + 2 * 2048 + u.pn * 256 + bj * 128 + wc * 32 + 8 * fq);
#pragma unroll
            for (int m = 0; m < 4; ++m) {
                const int row = row0 + ai * 128 + m * 16;
#pragma unroll
                for (int bj = 0; bj < 2; ++bj) {
                    const int col = u.pn * 256 + bj * 128 + wc * 32 + 8 * fq;
                    const u32x4 g = gv[m][bj];
                    const f32x4 v0 = acc[ai][bj][m][0] * (f32x4){fmaxf(bflo(g.x), GMIN), fmaxf(bfhi(g.x), GMIN), fmaxf(bflo(g.y), GMIN), fmaxf(bfhi(g.y), GMIN)};
                    const f32x4 v1 = acc[ai][bj][m][1] * (f32x4){fmaxf(bflo(g.z), GMIN), fmaxf(bfhi(g.z), GMIN), fmaxf(bflo(g.w), GMIN), fmaxf(bfhi(g.w), GMIN)};
                    u32x4 w; w.x = cvtpk(v0[0], v0[1]); w.y = cvtpk(v0[2], v0[3]); w.z = cvtpk(v1[0], v1[1]); w.w = cvtpk(v1[2], v1[3]);
                    *(u32x4*)(Mb + (size_t)row * DM + col) = w;
                }
            }
        }
    }
};

struct EpiE {
    static constexpr bool HAS_MID = false;
    const float* xin; float* xout; bf16_t* xb; float* ssq; bool dry;
    __device__ __forceinline__ void operator()(const f32x4 (&acc)[2][2][4][2], const GUnit& u, int wr, int wc, int fr, int fq) const {
        const int row0 = u.pm * 256 + wr * 64 + fr;
#pragma unroll
        for (int ai = 0; ai < 2; ++ai)
#pragma unroll
            for (int m = 0; m < 4; ++m) {
                const int row = row0 + ai * 128 + m * 16; float sq = 0.f;
#pragma unroll
                for (int bj = 0; bj < 2; ++bj) {
                    const int col = u.pn * 256 + bj * 128 + wc * 32 + 8 * fq;
                    const float* xp = xin + (size_t)row * DM + col;
                    const f32x4 v0 = acc[ai][bj][m][0] + *(const f32x4*)xp, v1 = acc[ai][bj][m][1] + *(const f32x4*)(xp + 4);
                    float* op = xout + (size_t)row * DM + col;
                    *(f32x4*)op = v0; *(f32x4*)(op + 4) = v1;
                    if (ssq) {
                        sq += (v0[0] * v0[0] + v0[1] * v0[1]) + (v0[2] * v0[2] + v0[3] * v0[3]) + (v1[0] * v1[0] + v1[1] * v1[1]) + (v1[2] * v1[2] + v1[3] * v1[3]);
                        u32x4 w; w.x = cvtpk(v0[0], v0[1]); w.y = cvtpk(v0[2], v0[3]); w.z = cvtpk(v1[0], v1[1]); w.w = cvtpk(v1[2], v1[3]);
                        *(u32x4*)(xb + (size_t)row * DM + col) = w;
                    }
                }
                if (ssq && !dry) { sq += __shfl_xor(sq, 16); sq += __shfl_xor(sq, 32); if (fq == 0) atomicAdd(ssq + row, sq); }
            }
    }
};

__device__ __forceinline__ int tr_srcmap(int kind, int n);
__device__ __forceinline__ void transpose_one(const float* W, int ldw, int Ndst, bf16_t* WT, int ldd, int kofs, const float* kscale, int kind,
                                              LAS float* scr, int it, int lane) {
    const int nblk = Ndst / 32;
    const int kb = it / nblk, nb = it % nblk, k0 = 64 * kb, n0 = 32 * nb;
    const int sc = tr_srcmap(kind, n0 + (lane & 31));
    float tv[32];
    const float* wp = W + (size_t)(k0 + (lane >> 5)) * ldw + (sc >= 0 ? sc : 0);
#pragma unroll
    for (int i = 0; i < 32; ++i) tv[i] = __builtin_nontemporal_load(wp + (size_t)(2 * i) * ldw);
    if (kscale) {
#pragma unroll
        for (int i = 0; i < 32; ++i) tv[i] *= kscale[k0 + 2 * i + (lane >> 5)];
    }
#pragma unroll
    for (int i = 0; i < 32; ++i) scr[(2 * i + (lane >> 5)) * 33 + (lane & 31)] = (sc >= 0) ? tv[i] : 0.f;
    LDS_WAIT(); asm volatile("" ::: "memory");
    const int c = lane & 7;
#pragma unroll
    for (int j = 0; j < 4; ++j) { const int n = (lane >> 3) + 8 * j; const LAS float* s = scr + (8 * c) * 33 + n;
        u32x4 o; o.x = pk2(s[0 * 33], s[1 * 33]); o.y = pk2(s[2 * 33], s[3 * 33]); o.z = pk2(s[4 * 33], s[5 * 33]); o.w = pk2(s[6 * 33], s[7 * 33]);
        *(u32x4*)(WT + (size_t)(n0 + n) * ldd + kofs + k0 + 8 * c) = o; }
    LDS_WAIT(); asm volatile("" ::: "memory");
}
struct MapId { __device__ __forceinline__ int operator()(int n) const { return n; } };
struct MapIn { __device__ __forceinline__ int operator()(int n) const {
    if (n < 3072) return n;
    if (n < 3328) return (n - 3072 < 64) ? n : -1;
    if (n < 4352) return n - 3328 + 3136;
    if (n < 5888) return n - 4352 + 4160;
    if (n < 6144) return (n - 5888 < 128) ? 5696 + (n - 5888) : -1;
    if (n < 6656) return n - 6144 + 5824;
    return n - 6656 + 6336; } };
struct MapUq { __device__ __forceinline__ int operator()(int n) const {
    const int h = n >> 8, p = n & 255;
    if (p < 128) return h * 192 + p;
    if (p < 192) { const int j = (p - 128) >> 3, e = (p - 128) & 7; return h * 192 + 128 + (e >> 2) * 32 + 4 * j + (e & 3); }
    return -1; } };

__device__ __forceinline__ int tr_srcmap(int kind, int n) { return kind == 1 ? MapIn()(n) : (kind == 2 ? MapUq()(n) : n); }

__device__ __forceinline__ void sincos_acc(float ang, float& sn, float& cs) {
    const double x = (double)ang;
    const double rev = x * 0.15915494309189535;
    const double fr = rev - __builtin_rint(rev);
    const double r = fr * 6.283185307179586476925;
    const double r2 = r * r;
    double ts = 1.0, ss = 1.0, tc = 1.0, sc2 = 1.0;
#pragma unroll
    for (int k = 1; k <= 13; ++k) { tc = -tc * r2 * (1.0 / (double)((2 * k - 1) * (2 * k))); sc2 += tc; ts = -ts * r2 * (1.0 / (double)((2 * k) * (2 * k + 1))); ss += ts; }
    sn = (float)(r * ss); cs = (float)sc2;
}

__device__ __forceinline__ int crow(int r, int hi) { return (r & 3) + 8 * (r >> 2) + 4 * hi; }
__device__ __forceinline__ int v_st(int k, int c) { const int kk = (k & ~0xC) | ((k & 4) << 1) | ((k & 8) >> 1); return ((kk >> 3) * 4 + (c >> 5)) * 512 + ((kk & 7) * 32 + (c & 31)) * 2; }
__device__ __forceinline__ int v_rd_base(int lane) { return ((lane & 3) << 3) | (((lane >> 2) & 3) << 6) | (((lane >> 4) & 1) << 5) | (((lane >> 5) & 1) << 8); }
constexpr int v_rd_off(int d0, int ks, int half) { return d0 * 512 + ks * 4096 + half * 2048; }
template <int OFF> __device__ __forceinline__ s16x4 tr_read(int vb) {
    s16x4 r; asm volatile("ds_read_b64_tr_b16 %0, %1 offset:%2" : "=&v"(r) : "v"(vb), "i"(OFF) : "memory"); return r;
}
template <int D0> __device__ __forceinline__ void pv_one(f32x16& od, int vb, bf16x8 pa0, bf16x8 pa1, bf16x8 pa2, bf16x8 pa3) {
    const s16x4 l0 = tr_read<v_rd_off(D0, 0, 0)>(vb), h0 = tr_read<v_rd_off(D0, 0, 1)>(vb), l1 = tr_read<v_rd_off(D0, 1, 0)>(vb), h1 = tr_read<v_rd_off(D0, 1, 1)>(vb);
    const s16x4 l2 = tr_read<v_rd_off(D0, 2, 0)>(vb), h2 = tr_read<v_rd_off(D0, 2, 1)>(vb), l3 = tr_read<v_rd_off(D0, 3, 0)>(vb), h3 = tr_read<v_rd_off(D0, 3, 1)>(vb);
    asm volatile("s_waitcnt lgkmcnt(0)" ::: "memory"); __builtin_amdgcn_sched_barrier(0);
#define PK(L, H) (bf16x8){L[0], L[1], L[2], L[3], H[0], H[1], H[2], H[3]}
    od = __builtin_amdgcn_mfma_f32_32x32x16_bf16(pa0, PK(l0, h0), od, 0, 0, 0);
    od = __builtin_amdgcn_mfma_f32_32x32x16_bf16(pa1, PK(l1, h1), od, 0, 0, 0);
    od = __builtin_amdgcn_mfma_f32_32x32x16_bf16(pa2, PK(l2, h2), od, 0, 0, 0);
    od = __builtin_amdgcn_mfma_f32_32x32x16_bf16(pa3, PK(l3, h3), od, 0, 0, 0);
#undef PK
}
#define PK4(P, BASE, OUT) do { unsigned a0 = cvtpk(P[BASE + 0], P[BASE + 1]), a1 = cvtpk(P[BASE + 2], P[BASE + 3]);   \
    unsigned b0 = cvtpk(P[BASE + 4], P[BASE + 5]), b1 = cvtpk(P[BASE + 6], P[BASE + 7]);                              \
    auto r0 = __builtin_amdgcn_permlane32_swap(a0, b0, false, false); auto r1 = __builtin_amdgcn_permlane32_swap(a1, b1, false, false); \
    u32x4 w_ = {r0[0], r1[0], r0[1], r1[1]}; OUT = __builtin_bit_cast(bf16x8, w_); } while (0)

__device__ __forceinline__ void sb_block(f32x16& Z, int keyb, int rowi, int hi, float R, float& E) {
#pragma unroll
    for (int g = 3; g >= 0; --g) {
        float lf[4], zz[4]; bool vd[4];
#pragma unroll
        for (int q = 0; q < 4; ++q) {
            const float z = Z[4 * g + q] * SCALE_SB; const bool valid = (keyb + 8 * g + q) < rowi;
            const float sp = fmaxf(z, 0.f) + __logf(1.f + __expf(-fabsf(z)));
            lf[q] = valid ? -sp : 0.f; zz[q] = z; vd[q] = valid;
        }
        const float ex3 = 0.f, ex2 = lf[3], ex1 = ex2 + lf[2], ex0 = ex1 + lf[1], G = ex0 + lf[0];
        const float Gp = __shfl_xor(G, 32);
        const float off = R + E + (hi == 0 ? Gp : 0.f);
        Z[4 * g + 0] = vd[0] ? __expf(zz[0] + lf[0] + off + ex0) : 0.f;
        Z[4 * g + 1] = vd[1] ? __expf(zz[1] + lf[1] + off + ex1) : 0.f;
        Z[4 * g + 2] = vd[2] ? __expf(zz[2] + lf[2] + off + ex2) : 0.f;
        Z[4 * g + 3] = vd[3] ? __expf(zz[3] + lf[3] + off + ex3) : 0.f;
        E += G + Gp;
    }
}

template <int DQK, bool SBM>
__device__ __forceinline__ void attn_unit(LAS unsigned char* lds, const bf16_t* Qp, int ldq, const bf16_t* Kp, int ldk, const bf16_t* Vp, int ldv,
                                          const bf16_t* Gp, int ldg, bf16_t* Op, int ldo, int qb) {
    constexpr int KROW = DQK * 2, KT_BYTES = 64 * KROW, VT_BYTES = 64 * 128 * 2, NKP = DQK / 64, ND0 = DQK / 16, PPR = DQK / 8;
    int tid = threadIdx.x; asm volatile("" : "+v"(tid));
    const int wid = __builtin_amdgcn_readfirstlane(tid >> 6), lane = tid & 63, r32 = lane & 31, hi = lane >> 5;
    LAS unsigned char* Kl = lds; LAS unsigned char* Vl = lds + 3 * KT_BYTES;
    LAS float* wscr = (LAS float*)(lds + LDS_SCR + 9216) + wid * 64;
    LAS int* flags = (LAS int*)(lds + LDS_SCR + 11264);
    bf16x8 qr[ND0];
    { const bf16_t* Qw = Qp + (size_t)(wid * 32 + r32) * ldq + hi * 8;
#pragma unroll
      for (int d0 = 0; d0 < ND0; ++d0) qr[d0] = *(const bf16x8*)(Qw + d0 * 16); }
    f32x16 o[4];
#pragma unroll
    for (int d = 0; d < 4; ++d)
#pragma unroll
        for (int r = 0; r < 16; ++r) o[d][r] = 0.f;
    float m_reg = -1e30f, l_reg = 0.f, R = 0.f;
    const int NT = 4 * qb + 4;
    const int vb0 = (int)(uintptr_t)Vl + v_rd_base(lane);
    int koff[NKP], voff[2];
#pragma unroll
    for (int i = 0; i < NKP; ++i) { const int q = (wid * NKP + i) * 64 + lane, row = q / PPR, c16 = q % PPR; koff[i] = row * ldk + ((c16 ^ (row & 7)) * 8); }
#pragma unroll
    for (int i = 0; i < 2; ++i) { const int q = (wid * 2 + i) * 64 + lane, st = q >> 5, wi = q & 31, kk = (st >> 2) * 8 + (wi >> 2), c = (st & 3) * 32 + (wi & 3) * 8;
        const int k = (kk & ~0xC) | ((kk & 4) << 1) | ((kk & 8) >> 1); voff[i] = k * ldv + c; }
#define ISSUE(kt, b) do { _Pragma("unroll") for (int i = 0; i < NKP; ++i) __builtin_amdgcn_global_load_lds((const unsigned*)(Kp + (size_t)(kt) * 64 * ldk + koff[i]), \
            (LAS unsigned*)(Kl + (b) * KT_BYTES + (wid * NKP + i) * 1024), 16, 0, 0); \
        _Pragma("unroll") for (int i = 0; i < 2; ++i) __builtin_amdgcn_global_load_lds((const unsigned*)(Vp + (size_t)(kt) * 64 * ldv + voff[i]), \
            (LAS unsigned*)(Vl + (b) * VT_BYTES + (wid * 2 + i) * 1024), 16, 0, 0); } while (0)
    ISSUE(SBM ? NT - 1 : 0, 0);
    if (NT > 1) { ISSUE(SBM ? NT - 2 : 1, 1); if constexpr (NKP == 3) asm volatile("s_waitcnt vmcnt(5)" ::: "memory"); else asm volatile("s_waitcnt vmcnt(4)" ::: "memory"); }
    else asm volatile("s_waitcnt vmcnt(0)" ::: "memory");
    __syncthreads();
    const int rowi = 256 * qb + 32 * wid + r32;
    for (int it = 0; it < NT; ++it) {
        const int kt = SBM ? NT - 1 - it : it, buf = it % 3;
        if (it + 2 < NT) ISSUE(SBM ? kt - 2 : kt + 2, (it + 2) % 3);
        const bool active = SBM ? (64 * kt <= 256 * qb + 32 * wid + 30) : (kt <= 4 * qb + (wid >> 1));
        if (active) {
            f32x16 p0, p1;
#pragma unroll
            for (int r = 0; r < 16; ++r) { p0[r] = 0.f; p1[r] = 0.f; }
            LAS unsigned char* Kb = Kl + buf * KT_BYTES;
#pragma unroll
            for (int dl = 0; dl < 4; ++dl) {
                LAS unsigned char* kb_dl = Kb + r32 * KROW + ((dl * 32 + hi * 16) ^ ((r32 & 7) << 4));
#pragma unroll
                for (int dh = 0; dh < ND0 / 4; ++dh) {
                    const bf16x8 b0 = *(const LAS bf16x8*)(kb_dl + dh * 128);
                    const bf16x8 b1 = *(const LAS bf16x8*)(kb_dl + dh * 128 + 32 * KROW);
                    p0 = __builtin_amdgcn_mfma_f32_32x32x16_bf16(b0, qr[4 * dh + dl], p0, 0, 0, 0);
                    p1 = __builtin_amdgcn_mfma_f32_32x32x16_bf16(b1, qr[4 * dh + dl], p1, 0, 0, 0); }
                __builtin_amdgcn_sched_barrier(0); }
            if constexpr (SBM) {
                float E = 0.f;
                sb_block(p1, kt * 64 + 32 + 4 * hi, rowi, hi, R, E);
                sb_block(p0, kt * 64 + 4 * hi, rowi, hi, R, E);
                R += E;
            } else {
                float pmax = p0[0];
#pragma unroll
                for (int r = 1; r < 16; ++r) pmax = fmaxf(pmax, p0[r]);
#pragma unroll
                for (int r = 0; r < 16; ++r) pmax = fmaxf(pmax, p1[r]);
                pmax = fmaxf(pmax, __shfl_xor(pmax, 32));
                float mn = m_reg, alpha = 1.f;
                if (!__all(pmax - m_reg <= 8.f)) { mn = fmaxf(m_reg, pmax); alpha = __builtin_amdgcn_exp2f(m_reg - mn); m_reg = mn; }
                float ps = 0.f;
#pragma unroll
                for (int r = 0; r < 16; ++r) { p0[r] = __builtin_amdgcn_exp2f(p0[r] - mn); ps += p0[r]; }
#pragma unroll
                for (int r = 0; r < 16; ++r) { p1[r] = __builtin_amdgcn_exp2f(p1[r] - mn); ps += p1[r]; }
                ps += __shfl_xor(ps, 32);
                l_reg = l_reg * alpha + ps;
                if (__any(alpha < 1.f)) {
                    if (hi == 0) wscr[r32] = alpha;
                    LDS_WAIT();
#pragma unroll
                    for (int r = 0; r < 16; ++r) { const float al = wscr[crow(r, hi)];
#pragma unroll
                        for (int d = 0; d < 4; ++d) o[d][r] *= al; }
                }
            }
            bf16x8 pa0, pa1, pa2, pa3;
            PK4(p0, 0, pa0); PK4(p0, 8, pa1); PK4(p1, 0, pa2); PK4(p1, 8, pa3);
            const int vb = vb0 + buf * VT_BYTES;
            pv_one<0>(o[0], vb, pa0, pa1, pa2, pa3); pv_one<1>(o[1], vb, pa0, pa1, pa2, pa3); pv_one<2>(o[2], vb, pa0, pa1, pa2, pa3); pv_one<3>(o[3], vb, pa0, pa1, pa2, pa3);
        }
        if constexpr (SBM) { const int dn = __all(R < -104.f) ? 1 : 0; if (lane == 0) flags[(it & 1) * 8 + wid] = dn; }
        if (it + 2 < NT) { if constexpr (NKP == 3) asm volatile("s_waitcnt vmcnt(5)" ::: "memory"); else asm volatile("s_waitcnt vmcnt(4)" ::: "memory"); }
        else asm volatile("s_waitcnt vmcnt(0)" ::: "memory");
        __syncthreads();
        if constexpr (SBM) {
            int alld = 1;
#pragma unroll
            for (int w = 0; w < 8; ++w) alld &= flags[(it & 1) * 8 + w];
            if (alld) { asm volatile("s_waitcnt vmcnt(0)" ::: "memory"); break; }
        }
    }
    if constexpr (SBM) __syncthreads();
    if constexpr (!SBM) { if (hi == 0) wscr[r32] = l_reg; LDS_WAIT(); }
    LAS float* ot = (LAS float*)lds + wid * (32 * 132);
#pragma unroll
    for (int r = 0; r < 16; ++r) { const int orow = crow(r, hi);
        float rl = 1.f; if constexpr (!SBM) rl = __builtin_amdgcn_rcpf(wscr[orow]);
#pragma unroll
        for (int d0 = 0; d0 < 4; ++d0) ot[orow * 132 + d0 * 32 + r32] = o[d0][r] * rl; }
    LDS_WAIT();
    { const int er = lane >> 4, ec = (lane & 15) * 8;
      const bf16_t* Gw = Gp + (size_t)(wid * 32 + er) * ldg + ec; bf16_t* Ow = Op + (size_t)(wid * 32 + er) * ldo + ec;
      u32x4 gv[8];
#pragma unroll
      for (int ps = 0; ps < 8; ++ps) gv[ps] = *(const u32x4*)(Gw + (size_t)(ps * 4) * ldg);
#pragma unroll
      for (int ps = 0; ps < 8; ++ps) {
          const f32x4 a0 = *(const LAS f32x4*)(ot + (ps * 4 + er) * 132 + ec), a1 = *(const LAS f32x4*)(ot + (ps * 4 + er) * 132 + ec + 4);
          const u32x4 g = gv[ps];
          u32x4 w; w.x = cvtpk(a0[0] * bflo(g.x), a0[1] * bfhi(g.x)); w.y = cvtpk(a0[2] * bflo(g.y), a0[3] * bfhi(g.y));
          w.z = cvtpk(a1[0] * bflo(g.z), a1[1] * bfhi(g.z)); w.w = cvtpk(a1[2] * bflo(g.w), a1[3] * bfhi(g.w));
          *(u32x4*)(Ow + (size_t)(ps * 4) * ldo) = w;
          __builtin_amdgcn_sched_barrier(0);
      } }
    __syncthreads();
#undef ISSUE
}

__device__ __forceinline__ float rowsum16(float x) {
    x += __builtin_bit_cast(float, __builtin_amdgcn_update_dpp(0, __builtin_bit_cast(int, x), 0x128, 0xf, 0xf, false));
    x += __builtin_bit_cast(float, __builtin_amdgcn_update_dpp(0, __builtin_bit_cast(int, x), 0x124, 0xf, 0xf, false));
    x += __builtin_bit_cast(float, __builtin_amdgcn_update_dpp(0, __builtin_bit_cast(int, x), 0x122, 0xf, 0xf, false));
    x += __builtin_bit_cast(float, __builtin_amdgcn_update_dpp(0, __builtin_bit_cast(int, x), 0x121, 0xf, 0xf, false));
    return x;
}

__device__ __forceinline__ float wsum64(float x) {
    x = rowsum16(x);
    const int xi = __builtin_bit_cast(int, x);
    const float r0 = __builtin_bit_cast(float, __builtin_amdgcn_readlane(xi, 0)), r1 = __builtin_bit_cast(float, __builtin_amdgcn_readlane(xi, 16));
    const float r2 = __builtin_bit_cast(float, __builtin_amdgcn_readlane(xi, 32)), r3 = __builtin_bit_cast(float, __builtin_amdgcn_readlane(xi, 48));
    return (r0 + r1) + (r2 + r3);
}

template <int NB>
__device__ __forceinline__ void rw_finaliseN(int it0, int stride, const float* gng, const float* gnb, const float* rk, const float* OSC, const float* SCN, const bf16_t* P, bf16_t* ycat) {
    int tl = threadIdx.x; asm volatile("" : "+v"(tl)); const int lane = tl & 63;
    float ov[NB], rr[NB], kk_[NB], vv_[NB], gg[NB];
#pragma unroll
    for (int q = 0; q < NB; ++q) { const int it = it0 + q * stride, t = it >> 3, h = it & 7, b = t >> 12, s = t & (S - 1), ch = h * 64 + lane;
        ov[q] = OSC[(size_t)t * 512 + ch];
        const float* sp = SCN + ((size_t)(b * 8 + h) * S + s) * 384 + lane;
        rr[q] = sp[0]; kk_[q] = sp[128]; vv_[q] = sp[320];
        gg[q] = bf2f(P[(size_t)t * NP + PC_RG + ch]); }
#pragma unroll
    for (int q = 0; q < NB; ++q) { const int it = it0 + q * stride, t = it >> 3, h = it & 7, ch = h * 64 + lane;
        const float mu = wsum64(ov[q]) * (1.f / 64.f), d = ov[q] - mu, var = wsum64(d * d) * (1.f / 64.f);
        const float y = d * rsqrtf(var + 64e-5f) * gng[ch] + gnb[ch];
        const float bonus = wsum64(rr[q] * kk_[q] * rk[ch]) * vv_[q];
        ycat[(size_t)t * DM + 1536 + ch] = (bf16_t)f2bf((y + bonus) * gg[q]); }
}

struct RwParams { const float* PRW; const float* mu; const float* w0; const float* w_up; const float* a0; const float* a_up; const float* k_k; const float* k_a; float* SCN; };

__device__ __forceinline__ void rw_prep(LAS unsigned char* lds, const RwParams& q, int tile) {
    int tid = threadIdx.x; asm volatile("" : "+v"(tid));
    const int lane = tid & 63, h = tid >> 6, t0 = tile * 32;
    LAS float* tw = (LAS float*)lds; LAS float* ta = tw + 2048;
#pragma unroll
    for (int e = 0; e < 8; ++e) { const int idx = tid + 512 * e, tk = idx >> 7, jj = idx & 127, t = t0 + tk;
        const float cur = q.PRW[(size_t)t * PRW_LD + 1536 + jj];
        const float prev = ((t & (S - 1)) == 0) ? 0.f : q.PRW[(size_t)(t - 1) * PRW_LD + 1536 + jj];
        const float sh = cur + q.mu[1536 + jj] * (prev - cur);
        if (jj < 64) tw[tk * 64 + jj] = tanhf(sh); else ta[tk * 64 + jj - 64] = sh; }
    __syncthreads();
    float aw[32], aa[32];
#pragma unroll
    for (int k = 0; k < 32; ++k) { aw[k] = 0.f; aa[k] = 0.f; }
    for (int j0 = 0; j0 < 64; j0 += 4) {
        float wu[4], au[4];
#pragma unroll
        for (int e = 0; e < 4; ++e) { wu[e] = q.w_up[(j0 + e) * 512 + tid]; au[e] = q.a_up[(j0 + e) * 512 + tid]; }
#pragma unroll
        for (int k = 0; k < 32; ++k) { const f32x4 x = *(const LAS f32x4*)(tw + k * 64 + j0), y = *(const LAS f32x4*)(ta + k * 64 + j0);
            aw[k] += (x[0] * wu[0] + x[1] * wu[1]) + (x[2] * wu[2] + x[3] * wu[3]);
            aa[k] += (y[0] * au[0] + y[1] * au[1]) + (y[2] * au[2] + y[3] * au[3]); }
    }
    const float w0c = q.w0[tid], a0c = q.a0[tid], kkc = q.k_k[tid], kac = q.k_a[tid], mur = q.mu[tid], muk = q.mu[512 + tid], muv = q.mu[1024 + tid];
    float pr = 0.f, pk = 0.f, pv = 0.f;
    if ((t0 & (S - 1)) != 0) { const float* pp = q.PRW + (size_t)(t0 - 1) * PRW_LD; pr = pp[tid]; pk = pp[512 + tid]; pv = pp[1024 + tid]; }
    const int b = t0 >> 12, s0 = t0 & (S - 1);
    float* dst = q.SCN + ((size_t)(b * 8 + h) * S + s0) * 384 + lane;
#pragma unroll
    for (int k = 0; k < 32; ++k) {
        const float* cp = q.PRW + (size_t)(t0 + k) * PRW_LD;
        const float cr = cp[tid], ck = cp[512 + tid], cv = cp[1024 + tid];
        const float rs_ = cr + mur * (pr - cr), ks_ = ck + muk * (pk - ck), vs_ = cv + muv * (pv - cv);
        pr = cr; pk = ck; pv = cv;
        const float uu = -(w0c + aw[k]);
        const float spl = fmaxf(uu, 0.f) + log1pf(expf(-fabsf(uu)));
        const float decay = expf(-expf(-spl - 0.5f));
        const float a = 1.f / (1.f + expf(-(a0c + aa[k])));
        float kk = ks_ * kkc; const float n2 = wsum64(kk * kk); kk = kk / fmaxf(sqrtf(n2), 1e-12f);
        const float kmod = ks_ * (1.f + (a - 1.f) * kac);
        float* d = dst + (size_t)k * 384;
        d[0] = rs_; d[64] = decay; d[128] = kmod; d[192] = -kk; d[256] = kk * a; d[320] = vs_;
    }
    __syncthreads();
}

__device__ __forceinline__ void rw_prep_mfma(LAS unsigned char* lds, const RwParams& q, int tile) {
    int tid = threadIdx.x; asm volatile("" : "+v"(tid));
    const int lane = tid & 63, h = __builtin_amdgcn_readfirstlane(tid >> 6), t0 = tile * 32, l16 = lane & 15, lq = lane >> 4;
    constexpr int TS = 65;
    LAS float* tw = (LAS float*)lds; LAS float* ta = tw + 32 * TS;
#pragma unroll
    for (int e = 0; e < 8; ++e) { const int idx = tid + 512 * e, tk = idx >> 7, jj = idx & 127, t = t0 + tk;
        const float cur = q.PRW[(size_t)t * PRW_LD + 1536 + jj];
        const float prev = ((t & (S - 1)) == 0) ? 0.f : q.PRW[(size_t)(t - 1) * PRW_LD + 1536 + jj];
        const float sh = cur + q.mu[1536 + jj] * (prev - cur);
        if (jj < 64) { const float e2 = __expf(-2.f * fabsf(sh)), th = (1.f - e2) * __builtin_amdgcn_rcpf(1.f + e2); tw[tk * TS + jj] = sh < 0.f ? -th : th; }
        else ta[tk * TS + jj - 64] = sh; }
    __syncthreads();
    f32x4 accW[2][4], accA[2][4];
#pragma unroll
    for (int tb = 0; tb < 2; ++tb)
#pragma unroll
        for (int cb = 0; cb < 4; ++cb) { accW[tb][cb] = (f32x4){0.f, 0.f, 0.f, 0.f}; accA[tb][cb] = (f32x4){0.f, 0.f, 0.f, 0.f}; }
    const float* wu = q.w_up + h * 64 + l16; const float* au = q.a_up + h * 64 + l16;
#pragma unroll 2
    for (int ks = 0; ks < 16; ++ks) {
        const int kk = 4 * ks + lq;
        float aW[2], aA[2], bW[4], bA[4];
#pragma unroll
        for (int tb = 0; tb < 2; ++tb) { aW[tb] = tw[(tb * 16 + l16) * TS + kk]; aA[tb] = ta[(tb * 16 + l16) * TS + kk]; }
#pragma unroll
        for (int cb = 0; cb < 4; ++cb) { bW[cb] = wu[kk * 512 + cb * 16]; bA[cb] = au[kk * 512 + cb * 16]; }
#pragma unroll
        for (int tb = 0; tb < 2; ++tb)
#pragma unroll
            for (int cb = 0; cb < 4; ++cb) { accW[tb][cb] = __builtin_amdgcn_mfma_f32_16x16x4f32(aW[tb], bW[cb], accW[tb][cb], 0, 0, 0);
                                             accA[tb][cb] = __builtin_amdgcn_mfma_f32_16x16x4f32(aA[tb], bA[cb], accA[tb][cb], 0, 0, 0); }
    }
    const int b = t0 >> 12, s0 = t0 & (S - 1);
#pragma unroll
    for (int tb = 0; tb < 2; ++tb) {
        const int tkb = tb * 16 + 4 * lq;
        const bool first = (((t0 + tkb) & (S - 1)) == 0);
        float kkv[4][4], av[4][4];
#pragma unroll
        for (int cb = 0; cb < 4; ++cb) {
            const int c = h * 64 + cb * 16 + l16;
            const float w0c = q.w0[c], a0c = q.a0[c], kkc = q.k_k[c], kac = q.k_a[c], mur = q.mu[c], muk = q.mu[512 + c], muv = q.mu[1024 + c];
            float pr = 0.f, pk = 0.f, pv = 0.f;
            if (!first) { const float* pp = q.PRW + (size_t)(t0 + tkb - 1) * PRW_LD; pr = pp[c]; pk = pp[512 + c]; pv = pp[1024 + c]; }
#pragma unroll
            for (int r = 0; r < 4; ++r) {
                const float* cp = q.PRW + (size_t)(t0 + tkb + r) * PRW_LD;
                const float cr = cp[c], ck = cp[512 + c], cv = cp[1024 + c];
                const float rs_ = cr + mur * (pr - cr), ks_ = ck + muk * (pk - ck), vs_ = cv + muv * (pv - cv);
                pr = cr; pk = ck; pv = cv;
                const float uu = -(w0c + accW[tb][cb][r]);
                const float spl = fmaxf(uu, 0.f) + __logf(1.f + __expf(-fabsf(uu)));
                const float decay = __expf(-__expf(-spl - 0.5f));
                const float a = __builtin_amdgcn_rcpf(1.f + __expf(-(a0c + accA[tb][cb][r])));
                kkv[cb][r] = ks_ * kkc; av[cb][r] = a;
                float* d = q.SCN + ((size_t)(b * 8 + h) * S + s0 + tkb + r) * 384 + cb * 16 + l16;
                d[0] = rs_; d[64] = decay; d[128] = ks_ * (1.f + (a - 1.f) * kac); d[320] = vs_;
            }
        }
#pragma unroll
        for (int r = 0; r < 4; ++r) {
            float n2 = (kkv[0][r] * kkv[0][r] + kkv[1][r] * kkv[1][r]) + (kkv[2][r] * kkv[2][r] + kkv[3][r] * kkv[3][r]);
            n2 = rowsum16(n2);
            const float inv = __builtin_amdgcn_rsqf(fmaxf(n2, 1e-24f));
            float* d = q.SCN + ((size_t)(b * 8 + h) * S + s0 + tkb + r) * 384 + l16;
#pragma unroll
            for (int cb = 0; cb < 4; ++cb) { const float kn = kkv[cb][r] * inv; d[192 + cb * 16] = -kn; d[256 + cb * 16] = kn * av[cb][r]; }
        }
    }
    __syncthreads();
}

__device__ __forceinline__ void rw_scan(LAS unsigned char* lds, const float* SCN, float* OSC, int sb) {
    int tid = threadIdx.x; asm volatile("" : "+v"(tid));
    const int wid = __builtin_amdgcn_readfirstlane(tid >> 6), lane = tid & 63;
    const int bh = sb >> 2, rg = sb & 3, b = bh >> 3, h = bh & 7;
    const float* src = SCN + (size_t)bh * S * 384;
    constexpr int CH = 16, CHF = CH * 384, NCH = S / CH;
    LAS float* bufs = (LAS float*)lds;
    LAS float* pb = bufs + 4 * CHF;
    const int rowl = 4 * wid + (lane >> 4), cg4 = (lane & 15) * 4;
    f32x4 s = (f32x4){0.f, 0.f, 0.f, 0.f};
#define SCAN_ISSUE(ch) do { const float* sp_ = src + (size_t)(ch) * CHF + lane * 4; LAS float* dp_ = bufs + ((ch) & 3) * CHF; \
        _Pragma("unroll") for (int i = 0; i < 12; ++i) { const int j = (wid - 4) * 12 + i; \
            __builtin_amdgcn_global_load_lds((const unsigned*)(sp_ + j * 256), (LAS unsigned*)(dp_ + j * 256), 16, 0, 0); } } while (0)
    if (wid == 4 || wid == 5) { SCAN_ISSUE(0); SCAN_ISSUE(1); SCAN_ISSUE(2); asm volatile("s_waitcnt vmcnt(24)" ::: "memory"); }
    __syncthreads();
    for (int c = 0; c < NCH; ++c) {
        if (wid < 4) {
            const LAS float* bp = bufs + (c & 3) * CHF + cg4;
            const LAS float* vp = bufs + (c & 3) * CHF + 320 + 16 * rg + rowl;
            LAS float* pp = pb + (c & 1) * 4096 + wid * 64 + lane;
            f32x4 r4[3], w4[3], k4[3], a4[3], b4[3]; float vv[3];
            const unsigned ba = (unsigned)(uintptr_t)bp, va = (unsigned)(uintptr_t)vp;
#define LRD128(dst, addr, off) asm volatile("ds_read_b128 %0, %1 offset:%2" : "=v"(dst) : "v"(addr), "i"(off))
#define LRD32(dst, addr, off) asm volatile("ds_read_b32 %0, %1 offset:%2" : "=v"(dst) : "v"(addr), "i"(off))
#define RD_STEP(set, stp) do { LRD128(r4[set], ba, (stp) * 1536); LRD128(w4[set], ba, (stp) * 1536 + 256); LRD128(k4[set], ba, (stp) * 1536 + 512); \
        LRD128(a4[set], ba, (stp) * 1536 + 768); LRD128(b4[set], ba, (stp) * 1536 + 1024); LRD32(vv[set], va, (stp) * 1536); } while (0)
#define WAITK(n, set) asm volatile("s_waitcnt lgkmcnt(" #n ")" : "+v"(r4[set]), "+v"(w4[set]), "+v"(k4[set]), "+v"(a4[set]), "+v"(b4[set]), "+v"(vv[set]))
#define STEP_BODY(st, cu) do { const f32x4 sa4 = s * a4[cu]; float sa = (sa4[0] + sa4[1]) + (sa4[2] + sa4[3]); \
        const f32x4 t1 = s * w4[cu] + vv[cu] * k4[cu]; sa = rowsum16(sa); s = t1 + sa * b4[cu]; \
        const f32x4 o4 = s * r4[cu]; pp[(st) * 256] = (o4[0] + o4[1]) + (o4[2] + o4[3]); } while (0)
#define STEP(st) do { RD_STEP(((st) + 2) % 3, (st) + 2); WAITK(12, (st) % 3); STEP_BODY(st, (st) % 3); } while (0)
            RD_STEP(0, 0); RD_STEP(1, 1);
            STEP(0); STEP(1); STEP(2); STEP(3); STEP(4); STEP(5); STEP(6); STEP(7); STEP(8); STEP(9); STEP(10); STEP(11); STEP(12); STEP(13);
            WAITK(6, 14 % 3); STEP_BODY(14, 14 % 3);
            WAITK(0, 15 % 3); STEP_BODY(15, 15 % 3);
#undef STEP
#undef STEP_BODY
#undef WAITK
#undef RD_STEP
#undef LRD32
#undef LRD128
        } else if (wid < 6) {
            if (c + 3 < NCH) { SCAN_ISSUE(c + 3); asm volatile("s_waitcnt vmcnt(24)" ::: "memory"); }
            else if (c + 2 < NCH) asm volatile("s_waitcnt vmcnt(12)" ::: "memory");
            else asm volatile("s_waitcnt vmcnt(0)" ::: "memory");
        } else if (c > 0) {
            const int lt = tid - 384;
#pragma unroll
            for (int e = 0; e < 2; ++e) { const int oi = lt * 2 + e, st = oi >> 4, rl = oi & 15;
                const LAS f32x4* p4 = (const LAS f32x4*)(pb + ((c - 1) & 1) * 4096 + oi * 16);
                const f32x4 x0 = p4[0], x1 = p4[1], x2 = p4[2], x3 = p4[3];
                const f32x4 t = (x0 + x1) + (x2 + x3);
                OSC[((size_t)b * S + (c - 1) * CH + st) * 512 + h * 64 + 16 * rg + rl] = (t[0] + t[1]) + (t[2] + t[3]); }
        }
        asm volatile("s_waitcnt lgkmcnt(0)" ::: "memory"); __builtin_amdgcn_s_barrier(); asm volatile("" ::: "memory");
    }
    if (wid >= 6) { const int lt = tid - 384;
#pragma unroll
        for (int e = 0; e < 2; ++e) { const int oi = lt * 2 + e, st = oi >> 4, rl = oi & 15;
            const LAS f32x4* p4 = (const LAS f32x4*)(pb + ((NCH - 1) & 1) * 4096 + oi * 16);
            const f32x4 x0 = p4[0], x1 = p4[1], x2 = p4[2], x3 = p4[3];
            const f32x4 t = (x0 + x1) + (x2 + x3);
            OSC[((size_t)b * S + (NCH - 1) * CH + st) * 512 + h * 64 + 16 * rg + rl] = (t[0] + t[1]) + (t[2] + t[3]); } }
    __syncthreads();
#undef SCAN_ISSUE
}

#ifndef PHMASK
#define PHMASK 127
#endif
#ifndef DUPMASK
#define DUPMASK 0
#endif

struct Args { const float* in[23]; float* out; unsigned char* ws; int ph_lo, ph_hi; };

__global__ void __launch_bounds__(512) fwd(Args a) {
    extern __shared__ __attribute__((aligned(16))) unsigned char lds_raw[];
    LAS unsigned char* lds = (LAS unsigned char*)lds_raw;
    cg::grid_group grid = cg::this_grid();
    const int tid = threadIdx.x, lane = tid & 63, wave = __builtin_amdgcn_readfirstlane(tid >> 6);
    const int G = gridDim.x, bx = blockIdx.x, vc = vblock(bx, G);
    const int gw = bx * 8 + wave, ngw = G * 8;
    unsigned char* ws = a.ws;
    float* ctl = (float*)(ws + WS_CTL);
    float* rope = (float*)(ws + WS_ROPE);
    bf16_t* xb = (bf16_t*)(ws + WS_XB); bf16_t* P = (bf16_t*)(ws + WS_P); float* PRW = (float*)(ws + WS_PRW);
    bf16_t* Qf = (bf16_t*)(ws + WS_QF); bf16_t* Kf = (bf16_t*)(ws + WS_KF); bf16_t* Vf = (bf16_t*)(ws + WS_VF);
    float* SCN = (float*)(ws + WS_SCN); float* OSC = (float*)(ws + WS_OSC); bf16_t* ycat = (bf16_t*)(ws + WS_YCAT);
    float* M32 = (float*)(ws + WS_MRG32); bf16_t* Mb = (bf16_t*)(ws + WS_MRGB);
    const float* x_in = a.in[0];
    int ph = 0;
#define PH_ON() (ph >= a.ph_lo && ph < a.ph_hi)
    volatile LAS unsigned* xb_st = (volatile LAS unsigned*)(lds + LDS_BYTES - 16);
    if (tid < 4) xb_st[tid] = 0u;
    __syncthreads();
    XcdBarrier xbar = xcd_barrier_post((unsigned*)(ws + WS_CTL) + CTL_QUEUE + 32768, xb_st);
#define GBAR() xcd_barrier(xbar)
    if (a.ph_lo < 0) grid.sync();
#define SEAM() do { if (ph + 1 > a.ph_lo && ph + 1 < a.ph_hi) { GBAR(); } ++ph; } while (0)

    for (int rep = 0; rep < (((DUPMASK) & 1) ? 2 : 1); ++rep) { if (rep) GBAR(); if (PH_ON() && (PHMASK & 1)) {
        LAS float* scr = (LAS float*)(lds + wave * 8704);
        {
            constexpr int I_IN = 32 * 400, I_UQ = 8 * 64, I_UKV = 8 * 64, I_SB = 8 * 64, I_MLA = 16 * 64, I_RW = 8 * 64, I_OUT = 32 * 64;
            constexpr int I_LAYER = I_IN + I_UQ + I_UKV + I_SB + I_MLA + I_RW + I_OUT;
            for (int it = gw; it < 2 * I_LAYER; it += ngw) {
                const int l = it >= I_LAYER; int r = it - l * I_LAYER;
                bf16_t* wbr = (bf16_t*)(ws + WS_WBR) + (size_t)l * DM * DM;
                if (r < I_IN) { transpose_one(a.in[2] + (size_t)l * DM * 12480, 12480, NP, (bf16_t*)(ws + WS_WIN) + (size_t)l * NP * DM, DM, 0, a.in[1] + l * DM, 1, scr, r, lane); continue; } r -= I_IN;
                if (r < I_OUT) { transpose_one(a.in[22] + (size_t)l * DM * DM, DM, DM, (bf16_t*)(ws + WS_WOUT) + (size_t)l * DM * DM, DM, 0, nullptr, 0, scr, r, lane); continue; } r -= I_OUT;
                if (r < I_MLA) { transpose_one(a.in[20] + (size_t)l * 1024 * DM, DM, DM, wbr, DM, 512, nullptr, 0, scr, r, lane); continue; } r -= I_MLA;
                if (r < I_UQ) { transpose_one(a.in[5] + (size_t)l * 512 * 1536, 1536, 2048, (bf16_t*)(ws + WS_WUQ) + (size_t)l * 2048 * 512, 512, 0, a.in[3] + l * 512, 2, scr, r, lane); continue; } r -= I_UQ;
                if (r < I_UKV) { transpose_one(a.in[6] + (size_t)l * 512 * 2048, 2048, 2048, (bf16_t*)(ws + WS_WUKV) + (size_t)l * 2048 * 512, 512, 0, a.in[4] + l * 512, 0, scr, r, lane); continue; } r -= I_UKV;
                if (r < I_SB) { transpose_one(a.in[19] + (size_t)l * 512 * DM, DM, DM, wbr, DM, 0, nullptr, 0, scr, r, lane); continue; } r -= I_SB;
                transpose_one(a.in[21] + (size_t)l * 512 * DM, DM, DM, wbr, DM, 1536, nullptr, 0, scr, r, lane);
            }
        }
        for (int m = gw; m < T; m += ngw) {
            const f32x4* xr = (const f32x4*)(x_in + (size_t)m * DM) + lane; float sq = 0.f;
            u32x2* o8 = (u32x2*)(xb + (size_t)m * DM) + lane;
#pragma unroll
            for (int j = 0; j < 8; ++j) { const f32x4 v = __builtin_nontemporal_load(xr + 64 * j); sq += (v[0] * v[0] + v[1] * v[1]) + (v[2] * v[2] + v[3] * v[3]);
                u32x2 w; w.x = pk2(v[0], v[1]); w.y = pk2(v[2], v[3]); o8[64 * j] = w; }
            sq = wave_sum(sq);
            if (lane == 0) ctl[CTL_SSQX + m] = sq;
        }
        for (int e = bx * 512 + tid; e < S * 32; e += G * 512) {
            const int pos = e >> 5, i = e & 31;
            double f = 1.0; for (int k = 0; k < i; ++k) f *= 0.7498942093324559;
            const float ff = (float)f, ang = (float)pos * ff;
            float sn, cs; sincos_acc(ang, sn, cs);
            rope[e] = cs; rope[S * 32 + e] = sn;
        }
    } }
    SEAM();

    for (int l = 0; l < 2; ++l) {
        float* ssqx = ctl + CTL_SSQX + l * T; float* ssq_cq = ctl + CTL_SSQCQ + l * T; float* ssq_ckv = ctl + CTL_SSQCKV + l * T; float* ssq_kr = ctl + CTL_SSQKR + l * T;
        if (PH_ON()) {
            SchedA1 Sd{(const char*)xb, (const char*)((bf16_t*)(ws + WS_WIN) + (size_t)l * NP * DM), G, vc, (G == 256) ? 32 : 0};
            EpiA E{P, PRW, ssqx, ssq_cq, ssq_ckv, ssq_kr};
            pg8::gemm_phase(lds, DM, DM, Sd, E);
        }
        SEAM();
        if (PH_ON()) {
            RwParams rp{PRW, a.in[9] + l * 1664, a.in[10] + l * 512, a.in[11] + (size_t)l * 64 * 512, a.in[12] + l * 512, a.in[13] + (size_t)l * 64 * 512,
                        a.in[14] + l * 512, a.in[15] + l * 512, SCN};
            for (int tile = bx; tile < 256; tile += G) rw_prep_mfma(lds, rp, tile);
        }
        SEAM();
        for (int rep = 0; rep < 1; ++rep) { if (PH_ON()) {
            const int nscan = (G == 256) ? 64 : 0;
            constexpr int A2_MAIN = 43 * 32 - 32;
            unsigned* sbar = (unsigned*)(ws + WS_CTL) + CTL_QUEUE + 2048;
            const unsigned nsub = (unsigned)(G - nscan);
            if (bx < nscan) {
                rw_scan(lds, SCN, OSC, ((bx & 15) << 2) | (bx >> 4));
                {
                    const int bh = bx & 15, rgq = bx >> 4, hb = bh >> 3, hh = bh & 7;
                    grid_bar((unsigned*)(ws + WS_CTL) + CTL_QUEUE + 4096 + 64 * bh, 4u * (unsigned)(l + 1));
                    if (tid == 0) { while (__hip_atomic_load(sbar, __ATOMIC_RELAXED, __HIP_MEMORY_SCOPE_AGENT) < nsub * (unsigned)(2 * l + 1)) __builtin_amdgcn_s_sleep(8);
                                    __builtin_amdgcn_fence(__ATOMIC_ACQUIRE, "agent"); asm volatile("s_waitcnt vmcnt(0)" ::: "memory"); }
                    __syncthreads();
                    for (int i4 = wave * 8; i4 < 1024; i4 += 64) {
                        rw_finaliseN<8>(((hb * S + 1024 * rgq + i4) << 3) + hh, 8, a.in[17] + l * 512, a.in[18] + l * 512, a.in[16] + l * 512, OSC, SCN, P, ycat);
                    }
                }
                if (tid == 0) { while (__hip_atomic_load(sbar, __ATOMIC_RELAXED, __HIP_MEMORY_SCOPE_AGENT) < nsub * (unsigned)(2 * l + 2)) __builtin_amdgcn_s_sleep(8);
                                __builtin_amdgcn_fence(__ATOMIC_ACQUIRE, "agent"); asm volatile("s_waitcnt vmcnt(0)" ::: "memory"); }
                __syncthreads();
            } else {
                if (nscan == 0) { for (int sb = bx; sb < 64; sb += G) rw_scan(lds, SCN, OSC, sb); }
                {   SchedA2 Sd{(const char*)xb, (const char*)((bf16_t*)(ws + WS_WIN) + (size_t)l * NP * DM), bx - nscan, G - nscan, nscan ? A2_MAIN : 43 * 32};
                    EpiA E{P, PRW, ssqx, ssq_cq, ssq_ckv, ssq_kr};
                    pg8::gemm_phase(lds, DM, DM, Sd, E); }
                grid_bar(sbar, nsub * (unsigned)(2 * l + 1));
                {   SchedB Sd{(const char*)P, (const char*)((bf16_t*)(ws + WS_WUQ) + (size_t)l * 2048 * 512), (const char*)((bf16_t*)(ws + WS_WUKV) + (size_t)l * 2048 * 512), G - nscan, vblock(bx - nscan, G - nscan)};
                    EpiB E{Qf, Kf, Vf, P, ssq_cq, ssq_ckv, ssq_kr, a.in[7] + l * 192, a.in[8] + l * 192, rope, (LAS float*)(lds + LDS_SCR)};
                    pg8::gemm_phase(lds, NP, 512, Sd, E); }
                grid_bar(sbar, nsub * (unsigned)(2 * l + 2));
            }
            unsigned* queue = (unsigned*)(ws + WS_CTL) + CTL_QUEUE + l * 64 + rep * 32;
            LAS unsigned* ubox = (LAS unsigned*)(lds + LDS_SCR + 8192);
            for (;;) {
#if defined(DUPC_SCANONLY)
                if (rep) break;
#endif
                if (tid == 0) *ubox = atomicAdd(queue, 1u);
                __syncthreads();
                const unsigned u = *ubox;
                __syncthreads();
                if (u >= 384u) break;
                if (u < 256u) {
                    const int qb = 15 - (int)(u >> 4), bh = u & 15, b = bh >> 3, h = bh & 7;
                    const size_t t0 = (size_t)b * S + qb * 256, tb = (size_t)b * S;
#ifndef NO_MLA
                    attn_unit<192, false>(lds, Qf + t0 * 1536 + h * 192, 1536, Kf + tb * 1536 + h * 192, 1536, Vf + tb * 1024 + h * 128, 1024,
                                          P + t0 * NP + PC_MG + h * 128, NP, ycat + t0 * DM + 512 + h * 128, DM, qb);
#endif
                } else {
                    const unsigned u2 = u - 256u; const int qb = 15 - (int)(u2 >> 3), bh = u2 & 7, b = bh >> 2, h = bh & 3;
                    const size_t t0 = (size_t)b * S + qb * 256, tb = (size_t)b * S;
#ifndef NO_SB
                    attn_unit<128, true>(lds, P + t0 * NP + PC_SBQ + h * 128, NP, P + tb * NP + PC_SBK + h * 128, NP, P + tb * NP + PC_SBV + h * 128, NP,
                                         P + t0 * NP + PC_SBG + h * 128, NP, ycat + t0 * DM + h * 128, DM, qb);
#endif
                }
            }
        } }
        SEAM();
        if (PH_ON()) {
            if (G != 256) { for (int it0 = gw * 4; it0 < T * 8; it0 += ngw * 4) rw_finaliseN<4>(it0, 1, a.in[17] + l * 512, a.in[18] + l * 512, a.in[16] + l * 512, OSC, SCN, P, ycat); }
        }
        if (G != 256) { SEAM(); } else { ++ph; }
        for (int rep = 0; rep < (((DUPMASK) & 32) ? 2 : 1); ++rep) { if (rep) GBAR(); if (PH_ON() && (PHMASK & 32)) {
            SchedD Sd{(const char*)ycat, (const char*)((bf16_t*)(ws + WS_WBR) + (size_t)l * DM * DM), G, vc};
            EpiD E{Mb, P};
            pg8::gemm_phase(lds, DM, DM, Sd, E);
        } }
        SEAM();
        for (int rep = 0; rep < (((DUPMASK) & 64) ? 2 : 1); ++rep) { if (rep) GBAR(); if (PH_ON() && (PHMASK & 64)) {
            SchedE Sd{(const char*)Mb, (const char*)((bf16_t*)(ws + WS_WOUT) + (size_t)l * DM * DM), G, vc};
            if (rep && l == 1) break;
            EpiE E{l == 0 ? x_in : a.out, a.out, xb, l == 0 ? (ctl + CTL_SSQX + T) : nullptr, rep != 0};
            pg8::gemm_phase(lds, DM, DM, Sd, E);
        } }
        SEAM();
    }
}

#ifndef MK_MULTI
#define MK_MULTI 0
#endif
extern "C" void kernel_launch(void* const* d_in, const int* in_sizes, int n_in, void* d_out, int out_size, void* d_ws, size_t ws_size, hipStream_t stream) {
    static int grid = 0;
    if (grid == 0) {
        if (n_in != 23 || out_size != T * DM || ws_size < WS_END) { fprintf(stderr, "kernel_launch: unexpected shapes (n_in %d out %d ws %zu)\n", n_in, out_size, ws_size); grid = -1; return; }
        int dev = 0, cus = 0, per_cu = 0;
        (void)hipGetDevice(&dev);
        (void)hipDeviceGetAttribute(&cus, hipDeviceAttributeMultiprocessorCount, dev);
        (void)hipFuncSetAttribute((const void*)fwd, hipFuncAttributeMaxDynamicSharedMemorySize, LDS_BYTES);
        (void)hipOccupancyMaxActiveBlocksPerMultiprocessor(&per_cu, (const void*)fwd, 512, LDS_BYTES);
        if (per_cu < 1) per_cu = 1;
        grid = cus * per_cu;
    }
    if (grid < 0) return;
    (void)hipMemsetAsync((char*)d_ws + WS_CTL, 0, 1 * MiB, stream);
    Args a{};
    for (int i = 0; i < 23; ++i) a.in[i] = (const float*)d_in[i];
    a.out = (float*)d_out; a.ws = (unsigned char*)d_ws;
#if MK_MULTI
    for (int p = 0; p < 13; ++p) { a.ph_lo = p; a.ph_hi = p + 1; hipLaunchKernelGGL(fwd, dim3(grid), dim3(512), LDS_BYTES, stream, a); }
#else
    a.ph_lo = 0; a.ph_hi = 13;
    void* args[] = {&a};
    hipError_t e = hipLaunchCooperativeKernel((const void*)fwd, dim3(grid), dim3(512), args, LDS_BYTES, stream);
    if (e != hipSuccess) fprintf(stderr, "cooperative launch failed: %s (grid %d)\n", hipGetErrorString(e), grid);
#endif
}
```

```cpp
#include <hip/hip_runtime.h>
#include <hip/hip_cooperative_groups.h>
#include <cstdio>
#include <cstdint>
namespace cg = cooperative_groups;

#define LAS __attribute__((address_space(3)))
typedef unsigned short bf16_t;
typedef short bf16x8 __attribute__((ext_vector_type(8)));
typedef short s16x4 __attribute__((ext_vector_type(4)));
typedef float f32x2 __attribute__((ext_vector_type(2)));
typedef float f32x4 __attribute__((ext_vector_type(4)));
typedef float f32x16 __attribute__((ext_vector_type(16)));
typedef unsigned u32x4 __attribute__((ext_vector_type(4)));
typedef unsigned u32x2 __attribute__((ext_vector_type(2)));

constexpr int T = 8192, S = 4096, DM = 2048, NP = 12800;
constexpr int PRW_LD = 1792;
constexpr int PC_SBQ = 0, PC_SBK = 512, PC_SBV = 1024, PC_SBG = 1536, PC_CQ = 2048, PC_CKV = 2560, PC_KR = 3072, PC_MG = 3328,
              PC_RG = 6144, PC_GATE = 6656;
constexpr float EPS = 1e-6f;
constexpr float CQ_MLA = 0.10411754627697264f;
constexpr float SCALE_SB = 0.08838834764831845f;

constexpr size_t MiB = 1u << 20;
constexpr size_t WS_CTL = 0, WS_ROPE = 1 * MiB, WS_WIN = 2 * MiB, WS_WUQ = 102 * MiB, WS_WUKV = 106 * MiB, WS_WBR = 110 * MiB, WS_WOUT = 126 * MiB,
                 WS_XB = 142 * MiB, WS_P = 174 * MiB, WS_PRW = 374 * MiB, WS_QF = 430 * MiB, WS_KF = 454 * MiB, WS_VF = 478 * MiB, WS_SCN = 494 * MiB,
                 WS_OSC = 590 * MiB, WS_YCAT = 606 * MiB, WS_MRG32 = 638 * MiB, WS_MRGB = 702 * MiB, WS_END = 734 * MiB;
constexpr int CTL_SSQX = 0, CTL_SSQCQ = 2 * T, CTL_SSQCKV = 4 * T, CTL_SSQKR = 6 * T, CTL_QUEUE = 131072;

constexpr int LDS_RING = 131072, LDS_SCR = 131072, LDS_BYTES = 147456;

__device__ __forceinline__ unsigned f2bf(float f) { unsigned u = __builtin_bit_cast(unsigned, f); return (u + 0x7fffu + ((u >> 16) & 1u)) >> 16; }
__device__ __forceinline__ unsigned pk2(float lo, float hi) { return f2bf(lo) | (f2bf(hi) << 16); }
__device__ __forceinline__ unsigned cvtpk(float lo, float hi) { unsigned r; asm volatile("v_cvt_pk_bf16_f32 %0, %1, %2" : "=v"(r) : "v"(lo), "v"(hi)); return r; }
__device__ __forceinline__ float bf2f(unsigned short b) { return __builtin_bit_cast(float, (unsigned)b << 16); }
__device__ __forceinline__ float bflo(unsigned w) { return __builtin_bit_cast(float, w << 16); }
__device__ __forceinline__ float bfhi(unsigned w) { return __builtin_bit_cast(float, w & 0xffff0000u); }
__device__ __forceinline__ float wave_sum(float v) {
#pragma unroll
    for (int o = 1; o < 64; o <<= 1) v += __shfl_xor(v, o);
    return v;
}
__device__ __forceinline__ float fsigmoid(float x) { return __builtin_amdgcn_rcpf(1.f + __expf(-x)); }
__device__ __forceinline__ float fsilu(float x) { return x * fsigmoid(x); }
#define LDS_WAIT() asm volatile("s_waitcnt lgkmcnt(0)" ::: "memory")

namespace pg8 {
constexpr int BM = 256, BK = 64, HALF = 128, HTB = HALF * BK * 2;
__device__ __forceinline__ int lds_byte(int r, int c) { const int st = (r >> 4) * 2 + (c >> 5), rr = r & 15, cc = c & 31, ob = rr * 64 + cc * 2; return st * 1024 + (ob ^ (((ob >> 9) & 1) << 5)); }
__device__ __forceinline__ void stage_rc(int b, int& R, int& C) { const int st = b / 1024, sb = b % 1024, swz = sb ^ (((sb >> 9) & 1) << 5); R = (st >> 1) * 16 + swz / 64; C = (st & 1) * 32 + (swz % 64) / 2; }
__device__ __forceinline__ int perm32(int rho) { const int n = rho >> 4, i = rho & 15; return 8 * (i >> 2) + 4 * n + (i & 3); }

struct GUnit { const char* A; const char* B; int nt, pm, pn, aux; };

template <class Epi, class Sched>
__device__ __forceinline__ void gemm_phase(LAS unsigned char* lds, const int lda, const int ldb, const Sched& S, const Epi& E) {
    int tid = threadIdx.x; asm volatile("" : "+v"(tid));
    const int wid = __builtin_amdgcn_readfirstlane(tid >> 6), lane = tid & 63, wr = wid >> 2, wc = wid & 3, fr = lane & 15, fq = lane >> 4;
    unsigned voffA[2], voffB[2];
#pragma unroll
    for (int i = 0; i < 2; ++i) { int R, C; stage_rc(tid * 16 + i * 8192, R, C); const int Rb = (R & ~31) + perm32(R & 31);
        voffA[i] = (unsigned)(R * lda + C) * 2u; voffB[i] = (unsigned)(Rb * ldb + C) * 2u; }
    const size_t kstep = (size_t)(BK * 2);
    const size_t hstepA = (size_t)HALF * lda * 2, hstepB = (size_t)HALF * ldb * 2;
    const unsigned ldsw = (unsigned)wid * 1024u;
    const int aoff = lds_byte(wr * 64 + fr, fq * 8), boff = lds_byte(wc * 32 + fr, fq * 8);
#define PG8_SA(b, h) (((b) * 2 + (h)) * HTB)
#define PG8_SB(b, h) ((4 + (b) * 2 + (h)) * HTB)
#define PG8_STAGE(bufoff, gbase, voff) do { _Pragma("unroll") for (int _i = 0; _i < 2; ++_i) \
        __builtin_amdgcn_global_load_lds((const unsigned*)((const char*)(gbase) + (voff)[_i]), (LAS unsigned*)(lds + (bufoff) + ldsw + _i * 8192), 16, 0, 0); } while (0)
#define PG8_LDA(dst, b, h) do { _Pragma("unroll") for (int m = 0; m < 4; ++m) _Pragma("unroll") for (int k = 0; k < 2; ++k) dst[m][k] = *(const LAS bf16x8*)(lds + PG8_SA(b, h) + aoff + m * 2048 + k * 1024); } while (0)
#define PG8_LDB(dst, b, h) do { _Pragma("unroll") for (int n = 0; n < 2; ++n) _Pragma("unroll") for (int k = 0; k < 2; ++k) dst[n][k] = *(const LAS bf16x8*)(lds + PG8_SB(b, h) + boff + n * 2048 + k * 1024); } while (0)
#define PG8_MMA(ai, bj, At, Bt) do { __builtin_amdgcn_s_setprio(1); _Pragma("unroll") for (int m = 0; m < 4; ++m) _Pragma("unroll") for (int n = 0; n < 2; ++n) _Pragma("unroll") for (int k = 0; k < 2; ++k) \
        acc[ai][bj][m][n] = __builtin_amdgcn_mfma_f32_16x16x32_bf16(Bt[n][k], At[m][k], acc[ai][bj][m][n], 0, 0, 0); __builtin_amdgcn_s_setprio(0); } while (0)
#define PG8_WAIT_V(n) asm volatile("s_waitcnt vmcnt(" #n ")" ::: "memory")
#define PG8_WAIT_L(n) asm volatile("s_waitcnt lgkmcnt(" #n ")" ::: "memory")
#define PG8_BAR __builtin_amdgcn_s_barrier()
#define PG8_SCHED __builtin_amdgcn_sched_barrier(0)
    GUnit cur, nxt; int ui = 0;
    if (!S.next(0, cur)) return;
    f32x4 acc[2][2][4][2];
#pragma unroll
    for (int a = 0; a < 2; ++a)
#pragma unroll
        for (int b = 0; b < 2; ++b)
#pragma unroll
            for (int m = 0; m < 4; ++m)
#pragma unroll
                for (int n = 0; n < 2; ++n) acc[a][b][m][n] = (f32x4){0.f, 0.f, 0.f, 0.f};
    bf16x8 At[4][2], B0[2][2], B1[2][2];
    const char* cA = cur.A; const char* cB = cur.B;
    PG8_STAGE(PG8_SB(0, 0), cB, voffB); PG8_STAGE(PG8_SB(0, 1), cB + hstepB, voffB); PG8_STAGE(PG8_SA(0, 0), cA, voffA); PG8_STAGE(PG8_SA(0, 1), cA + hstepA, voffA);
    if (wr == 1) PG8_BAR;
    PG8_WAIT_V(2); PG8_BAR;
    PG8_STAGE(PG8_SB(1, 0), cB + kstep, voffB); PG8_STAGE(PG8_SA(1, 0), cA + kstep, voffA); PG8_STAGE(PG8_SB(1, 1), cB + hstepB + kstep, voffB);
    PG8_WAIT_V(6); PG8_BAR;
    for (;;) {
        const bool has_next = S.next(ui + 1, nxt);
        const char* nA = has_next ? nxt.A : cA; const char* nB = has_next ? nxt.B : cB;
        const int nt = cur.nt;
        for (int t = 0; t < nt; t += 2) {
            if constexpr (Epi::HAS_MID) { if (t == 8 || t == 24) { int fr_ = fr, fq_ = fq; asm volatile("" : "+v"(fr_), "+v"(fq_)); E.mid(acc, cur, t, wr, wc, fr_, fq_); } }
            const bool last = (t == nt - 2);
            const char* a1 = cA + (size_t)(t + 1) * kstep;
            const char* a2 = last ? nA : cA + (size_t)(t + 2) * kstep; const char* b2 = last ? nB : cB + (size_t)(t + 2) * kstep;
            const char* a3 = a2 + kstep; const char* b3 = b2 + kstep;
            PG8_LDB(B0, 0, 0); PG8_LDB(B1, 0, 1); PG8_SCHED; PG8_LDA(At, 0, 0); PG8_STAGE(PG8_SA(1, 1), a1 + hstepA, voffA);
            PG8_WAIT_V(8); PG8_WAIT_L(0); PG8_BAR; PG8_MMA(0, 0, At, B0); PG8_MMA(0, 1, At, B1); PG8_BAR; PG8_SCHED;
            PG8_LDA(At, 0, 1); PG8_STAGE(PG8_SB(0, 0), b2, voffB); PG8_STAGE(PG8_SB(0, 1), b2 + hstepB, voffB); PG8_STAGE(PG8_SA(0, 0), a2, voffA);
            PG8_WAIT_V(8); PG8_WAIT_L(0); PG8_BAR; PG8_MMA(1, 0, At, B0); PG8_MMA(1, 1, At, B1); PG8_BAR; PG8_SCHED;
            PG8_LDB(B0, 1, 0); PG8_LDB(B1, 1, 1); PG8_SCHED; PG8_LDA(At, 1, 0); PG8_STAGE(PG8_SA(0, 1), a2 + hstepA, voffA);
            PG8_WAIT_V(8); PG8_WAIT_L(0); PG8_BAR; PG8_MMA(0, 0, At, B0); PG8_MMA(0, 1, At, B1); PG8_BAR; PG8_SCHED;
            PG8_LDA(At, 1, 1); PG8_STAGE(PG8_SB(1, 0), b3, voffB); PG8_STAGE(PG8_SB(1, 1), b3 + hstepB, voffB); PG8_STAGE(PG8_SA(1, 0), a3, voffA);
            PG8_WAIT_V(8); PG8_WAIT_L(0); PG8_BAR; PG8_MMA(1, 0, At, B0); PG8_MMA(1, 1, At, B1); PG8_BAR; PG8_SCHED;
        }
        if (wr == 0) PG8_BAR;
        { GUnit eu = cur; eu.pm = __builtin_amdgcn_readfirstlane(cur.pm); eu.pn = __builtin_amdgcn_readfirstlane(cur.pn); eu.aux = __builtin_amdgcn_readfirstlane(cur.aux);
          int wr_ = wr, wc_ = wc, fr_ = fr, fq_ = fq;
          asm volatile("" : "+s"(eu.pm), "+s"(eu.pn), "+s"(eu.aux), "+s"(wr_), "+s"(wc_), "+v"(fr_), "+v"(fq_));
          E(acc, eu, wr_, wc_, fr_, fq_); }
        if (!has_next) break;
#pragma unroll
        for (int a = 0; a < 2; ++a)
#pragma unroll
            for (int b = 0; b < 2; ++b)
#pragma unroll
                for (int m = 0; m < 4; ++m)
#pragma unroll
                    for (int n = 0; n < 2; ++n) acc[a][b][m][n] = (f32x4){0.f, 0.f, 0.f, 0.f};
        cur = nxt; cA = nA; cB = nB; ++ui;
        if (wr == 1) PG8_BAR;
    }
    PG8_WAIT_V(0);
    PG8_BAR;
#undef PG8_SA
#undef PG8_SB
#undef PG8_STAGE
#undef PG8_LDA
#undef PG8_LDB
#undef PG8_MMA
#undef PG8_WAIT_V
#undef PG8_WAIT_L
#undef PG8_SCHED
}
}
using pg8::GUnit;

#define XB_TMO      128
#define XB_XCNT(j)  (256  + 64 * (j))
#define XB_XSUB(j)  (1280 + 64 * (j))
#define XB_XGEN(j)  (2304 + 64 * (j))
#define XB_TOP      3328
#define XB_TOPGEN   3392
#define XCD_BAR_WORDS 3456
#define XB_SPIN_CAP (1u << 18)

__device__ __forceinline__ unsigned xb_ld(unsigned* p)              { return __hip_atomic_load(p, __ATOMIC_RELAXED, __HIP_MEMORY_SCOPE_AGENT); }
__device__ __forceinline__ unsigned xb_add(unsigned* p, unsigned v) { return __hip_atomic_fetch_add(p, v, __ATOMIC_RELAXED, __HIP_MEMORY_SCOPE_AGENT); }
__device__ __forceinline__ unsigned xb_xcc_id() { return (unsigned)__builtin_amdgcn_s_getreg((3 << 11) | 20) & 0xFu; }
#define XB_SPIN(cond, bar) do { unsigned _sp = 0; while (cond) { __builtin_amdgcn_s_sleep(1); \
    if ((++_sp & 255u) == 0u) { if (xb_ld(&(bar)[XB_TMO])) break; if (_sp > XB_SPIN_CAP) { atomicAdd(&(bar)[XB_TMO], 1u); break; } } } } while (0)

struct XcdBarrier {
    unsigned* bar; unsigned x;
    volatile LAS unsigned* st;
};

__device__ __forceinline__ XcdBarrier xcd_barrier_post(unsigned* bar, volatile LAS unsigned* st) {
    XcdBarrier b; b.bar = bar; b.x = xb_xcc_id(); b.st = st;
    if (threadIdx.x == 0) (void)xb_add(&bar[XB_XCNT(b.x)], 1u);
    return b;
}
__device__ __forceinline__ void xcd_barrier_complete(unsigned* bar, unsigned x, unsigned& nloc, unsigned& nx) {
    const unsigned G = gridDim.x * gridDim.y * gridDim.z;
    unsigned sum, cnt, mine, sp = 0u;
    for (;;) {
        sum = 0u; cnt = 0u; mine = 0u;
#pragma unroll
        for (unsigned j = 0; j < 16; ++j) { const unsigned c = xb_ld(&bar[XB_XCNT(j)]); sum += c; cnt += (c > 0u) ? 1u : 0u; mine = (j == x) ? c : mine; }
        if (sum == G) break;
        __builtin_amdgcn_s_sleep(1);
        if ((++sp & 255u) == 0u) { if (xb_ld(&bar[XB_TMO])) break; if (sp > XB_SPIN_CAP) { atomicAdd(&bar[XB_TMO], 1u); break; } }
    }
    nloc = mine > 0u ? mine : 1u; nx = cnt > 0u ? cnt : 1u;
}

__device__ __forceinline__ void xcd_barrier(const XcdBarrier& b) {
    asm volatile("s_waitcnt vmcnt(0)" ::: "memory");
    __syncthreads();
    if (threadIdx.x == 0) {
        unsigned* bar = b.bar;
        __builtin_amdgcn_s_waitcnt(0);
        unsigned nloc = b.st[0], nx = b.st[1];
        if (nloc == 0u) { xcd_barrier_complete(bar, b.x, nloc, nx); b.st[0] = nloc; b.st[1] = nx; }
        const unsigned old = xb_add(&bar[XB_XSUB(b.x)], 1u);
        const unsigned gen = old / nloc;
        if (old + 1u == (gen + 1u) * nloc) {
            __builtin_amdgcn_fence(__ATOMIC_RELEASE, "agent");
            asm volatile("s_waitcnt vmcnt(0)" ::: "memory");
            const unsigned og = xb_add(&bar[XB_TOP], 1u);
            const unsigned tg = og / nx;
            if (og + 1u == (tg + 1u) * nx) xb_add(&bar[XB_TOPGEN], 1u);
            else XB_SPIN(xb_ld(&bar[XB_TOPGEN]) == tg, bar);
            __builtin_amdgcn_fence(__ATOMIC_ACQUIRE, "agent");
            xb_add(&bar[XB_XGEN(b.x)], 1u);
            asm volatile("s_waitcnt vmcnt(0)" ::: "memory");
        } else {
            XB_SPIN(xb_ld(&bar[XB_XGEN(b.x)]) == gen, bar);
            __builtin_amdgcn_fence(__ATOMIC_ACQUIRE, "agent");
            asm volatile("s_waitcnt vmcnt(0)" ::: "memory");
        }
    }
    __syncthreads();
}


__device__ __forceinline__ void grid_bar(unsigned* cnt, unsigned target) {
    asm volatile("s_waitcnt vmcnt(0) lgkmcnt(0)" ::: "memory");
    __syncthreads();
    if (threadIdx.x == 0) {
        __builtin_amdgcn_fence(__ATOMIC_RELEASE, "agent");
        asm volatile("s_waitcnt vmcnt(0)" ::: "memory");
        __hip_atomic_fetch_add(cnt, 1u, __ATOMIC_RELAXED, __HIP_MEMORY_SCOPE_AGENT);
        while (__hip_atomic_load(cnt, __ATOMIC_RELAXED, __HIP_MEMORY_SCOPE_AGENT) < target) __builtin_amdgcn_s_sleep(1);
        __builtin_amdgcn_fence(__ATOMIC_ACQUIRE, "agent");
        asm volatile("s_waitcnt vmcnt(0)" ::: "memory");
    }
    __syncthreads();
}

__device__ __forceinline__ int vblock(int c, int G) { return (G % 8 == 0) ? (c % 8) * (G / 8) + c / 8 : c; }

struct SchedA {
    const char* A; const char* B; int G, c;
    __device__ __forceinline__ bool next(int i, GUnit& u) const {
        constexpr int nM = 32, nN = 50, nwg = nM * nN, NXCD = 8, WGM = 8;
        const long L = (long)i * G + c; if (L >= nwg) return false;
        int wgid = (int)L; { const int q = nwg / NXCD, r = nwg % NXCD, xcd = wgid % NXCD, off = wgid / NXCD; wgid = (xcd < r ? xcd * (q + 1) : r * (q + 1) + (xcd - r) * q) + off; }
        const int nig = WGM * nN, gid = wgid / nig, fm = gid * WGM, gsz = (nM - fm) < WGM ? (nM - fm) : WGM;
        u.pm = fm + ((wgid % nig) % gsz); u.pn = (wgid % nig) / gsz; u.nt = 32; u.aux = 0;
        u.A = A + (size_t)u.pm * 256 * DM * 2; u.B = B + (size_t)u.pn * 256 * DM * 2; return true;
    }
};
struct SchedA2 {
    const char* A; const char* B; int first, stride, limit;
    __device__ __forceinline__ bool next(int i, GUnit& u) const {
        constexpr int nM = 32, nN = 43, nwg = nM * nN, NXCD = 8, WGM = 8;
        const int L = first + i * stride; if (L >= limit) return false;
        int wgid = L; { const int q = nwg / NXCD, r = nwg % NXCD, xcd = wgid % NXCD, off = wgid / NXCD; wgid = (xcd < r ? xcd * (q + 1) : r * (q + 1) + (xcd - r) * q) + off; }
        const int nig = WGM * nN, gid = wgid / nig, fm = gid * WGM, gsz = (nM - fm) < WGM ? (nM - fm) : WGM;
        u.pm = fm + ((wgid % nig) % gsz); const int pn = (wgid % nig) / gsz; u.pn = pn < 17 ? pn : pn + 7; u.nt = 32; u.aux = 0;
        u.A = A + (size_t)u.pm * 256 * DM * 2; u.B = B + (size_t)u.pn * 256 * DM * 2; return true;
    }
};
struct SchedA1 {
    const char* A; const char* B; int G, vc, extra;
    __device__ __forceinline__ bool next(int i, GUnit& u) const {
        const int L = i * G + vc; if (L >= 224 + extra) return false;
        if (L >= 224) { SchedA2 s2{A, B, 43 * 32 - 32 + (L - 224), 1 << 20, 43 * 32}; return s2.next(0, u); }
        u.pm = L / 7; u.pn = 17 + L % 7; u.nt = 32; u.aux = 0;
        u.A = A + (size_t)u.pm * 256 * DM * 2; u.B = B + (size_t)u.pn * 256 * DM * 2; return true;
    }
};
struct SchedB {
    const char* P; const char* Wq; const char* Wkv; int G, vc;
    __device__ __forceinline__ bool next(int i, GUnit& u) const {
        const int L = i * G + vc; if (L >= 512) return false;
        const int isq = (L < 256), l2 = L & 255; u.pm = l2 >> 3; u.pn = l2 & 7; u.nt = 8; u.aux = isq ? 0 : 1;
        u.A = P + ((size_t)u.pm * 256 * NP + (isq ? PC_CQ : PC_CKV)) * 2; u.B = (isq ? Wq : Wkv) + (size_t)u.pn * 256 * 512 * 2; return true;
    }
};
struct SchedD {
    const char* Y; const char* W; int G, vc;
    __device__ __forceinline__ bool next(int i, GUnit& u) const {
        const int tile = i * G + vc; if (tile >= 256) return false;
        u.pm = tile >> 3; u.pn = tile & 7; u.aux = 0; u.nt = 32;
        u.A = Y + (size_t)u.pm * 256 * DM * 2; u.B = W + (size_t)u.pn * 256 * DM * 2; return true;
    }
};
struct SchedE {
    const char* A; const char* B; int G, vc;
    __device__ __forceinline__ bool next(int i, GUnit& u) const {
        const int tile = i * G + vc; if (tile >= 256) return false;
        u.pm = tile >> 3; u.pn = tile & 7; u.aux = 0; u.nt = 32;
        u.A = A + (size_t)u.pm * 256 * DM * 2; u.B = B + (size_t)u.pn * 256 * DM * 2; return true;
    }
};

struct EpiA {
    static constexpr bool HAS_MID = false;
    bf16_t* P; float* PRW; const float* ssqx; float* ssq_cq; float* ssq_ckv; float* ssq_kr;
    __device__ __forceinline__ void operator()(const f32x4 (&acc)[2][2][4][2], const GUnit& u, int wr, int wc, int fr, int fq) const {
        const int pn = u.pn;
        const int kind = (pn < 6) ? 0 : (pn < 8) ? 1 : (pn < 13) ? 0 : (pn < 17) ? 1 : (pn < 24) ? 3 : (pn < 26) ? 1 : 2;
        float* ssq = (pn >= 8 && pn < 10) ? ssq_cq : (pn >= 10 && pn < 12) ? ssq_ckv : (pn == 12) ? ssq_kr : nullptr;
        const int row0 = u.pm * 256 + wr * 64 + fr;
#pragma unroll
        for (int ai = 0; ai < 2; ++ai)
#pragma unroll
            for (int m = 0; m < 4; ++m) {
                const int row = row0 + ai * 128 + m * 16;
                const float rs = rsqrtf(ssqx[row] * (1.f / 2048.f) + EPS);
                float sq = 0.f;
#pragma unroll
                for (int bj = 0; bj < 2; ++bj) {
                    f32x4 v0 = acc[ai][bj][m][0] * rs, v1 = acc[ai][bj][m][1] * rs;
                    const int cl = bj * 128 + wc * 32 + 8 * fq;
                    if (kind == 3) {
                        float* o = PRW + (size_t)row * PRW_LD + (pn - 17) * 256 + cl;
                        *(f32x4*)o = v0; *(f32x4*)(o + 4) = v1;
                    } else {
                        if (ssq) sq += (v0[0] * v0[0] + v0[1] * v0[1]) + (v0[2] * v0[2] + v0[3] * v0[3]) + (v1[0] * v1[0] + v1[1] * v1[1]) + (v1[2] * v1[2] + v1[3] * v1[3]);
                        if (kind == 1) {
#pragma unroll
                            for (int e = 0; e < 4; ++e) { v0[e] = fsilu(v0[e]); v1[e] = fsilu(v1[e]); }
                        } else if (kind == 2) {
#pragma unroll
                            for (int e = 0; e < 4; ++e) { v0[e] = fsigmoid(v0[e]); v1[e] = fsigmoid(v1[e]); }
                        }
                        u32x4 w; w.x = cvtpk(v0[0], v0[1]); w.y = cvtpk(v0[2], v0[3]); w.z = cvtpk(v1[0], v1[1]); w.w = cvtpk(v1[2], v1[3]);
                        *(u32x4*)(P + (size_t)row * NP + pn * 256 + cl) = w;
                    }
                }
                if (ssq) { sq += __shfl_xor(sq, 16); sq += __shfl_xor(sq, 32); if (fq == 0) atomicAdd(ssq + row, sq); }
            }
    }
};

struct EpiB {
    static constexpr bool HAS_MID = false;
    bf16_t* Qf; bf16_t* Kf; bf16_t* Vf; const bf16_t* P; const float* ssq_cq; const float* ssq_ckv; const float* ssq_kr;
    const float* qn_g; const float* kn_g; const float* rope; LAS float* scr;
    __device__ __forceinline__ void operator()(const f32x4 (&acc)[2][2][4][2], const GUnit& u, int wr, int wc, int fr, int fq) const {
        const int h = u.pn; const bool isq = (u.aux == 0);
        const float* ssqA = isq ? ssq_cq : ssq_ckv;
        LAS float* part = scr; LAS float* rstdL = scr + 1024;
        const int row0 = u.pm * 256 + wr * 64 + fr;
        float sv[2][4], krv[2][4];
#pragma unroll
        for (int ai = 0; ai < 2; ++ai)
#pragma unroll
            for (int m = 0; m < 4; ++m) { const int row = row0 + ai * 128 + m * 16; sv[ai][m] = ssqA[row]; krv[ai][m] = isq ? 0.f : ssq_kr[row]; }
#pragma unroll
        for (int ai = 0; ai < 2; ++ai)
#pragma unroll
            for (int m = 0; m < 4; ++m) sv[ai][m] = rsqrtf(sv[ai][m] * (1.f / 512.f) + EPS);
#pragma unroll
        for (int ai = 0; ai < 2; ++ai)
#pragma unroll
            for (int m = 0; m < 4; ++m) {
                const float s = sv[ai][m];
                float sq = 0.f;
#pragma unroll
                for (int bj = 0; bj < 2; ++bj) {
                    if (!isq && bj == 1) continue;
                    const f32x4 v0 = acc[ai][bj][m][0] * s, v1 = acc[ai][bj][m][1] * s;
                    sq += (v0[0] * v0[0] + v0[1] * v0[1]) + (v0[2] * v0[2] + v0[3] * v0[3]) + (v1[0] * v1[0] + v1[1] * v1[1]) + (v1[2] * v1[2] + v1[3] * v1[3]);
                }
                sq += __shfl_xor(sq, 16); sq += __shfl_xor(sq, 32);
                if (fq == 0) part[(ai * 128 + wr * 64 + m * 16 + fr) * 4 + wc] = sq;
                __builtin_amdgcn_sched_barrier(0);
            }
        LDS_WAIT(); PG8_BAR;
        const float* gq = isq ? qn_g : kn_g;
        const int c0 = wc * 32 + 8 * fq;
        f32x4 g0 = *(const f32x4*)(gq + c0), g1 = *(const f32x4*)(gq + c0 + 4);
        const int j = 4 * wc + fq;
        f32x4 gr1 = (f32x4){0.f, 0.f, 0.f, 0.f}, gr2 = gr1;
        if (isq && wc < 2) { gr1 = *(const f32x4*)(qn_g + 128 + 4 * j); gr2 = *(const f32x4*)(qn_g + 160 + 4 * j); }
#pragma unroll
        for (int ai = 0; ai < 2; ++ai)
#pragma unroll
            for (int m = 0; m < 4; ++m) {
                const int rl = ai * 128 + wr * 64 + m * 16 + fr, row = u.pm * 256 + rl;
                const f32x4 pp = *(const LAS f32x4*)(part + rl * 4);
                float tot = (pp[0] + pp[1]) + (pp[2] + pp[3]);
                if (!isq) tot += krv[ai][m];
                const float rstd = rsqrtf(tot * (1.f / 192.f) + EPS);
                const float s = sv[ai][m];
                if (isq) {
                    const float f = s * rstd * CQ_MLA;
                    { const f32x4 v0 = acc[ai][0][m][0] * f * g0, v1 = acc[ai][0][m][1] * f * g1;
                      u32x4 w; w.x = cvtpk(v0[0], v0[1]); w.y = cvtpk(v0[2], v0[3]); w.z = cvtpk(v1[0], v1[1]); w.w = cvtpk(v1[2], v1[3]);
                      *(u32x4*)(Qf + (size_t)row * 1536 + h * 192 + c0) = w; }
                    if (wc < 2) {
                        const int pos = row & (S - 1);
                        const f32x4 cs = *(const f32x4*)(rope + pos * 32 + 4 * j), sn = *(const f32x4*)(rope + S * 32 + pos * 32 + 4 * j);
                        const f32x4 x1 = acc[ai][1][m][0] * f * gr1, x2 = acc[ai][1][m][1] * f * gr2;
                        const f32x4 y1 = x1 * cs - x2 * sn, y2 = x1 * sn + x2 * cs;
                        u32x4 w; w.x = cvtpk(y1[0], y1[1]); w.y = cvtpk(y1[2], y1[3]); w.z = cvtpk(y2[0], y2[1]); w.w = cvtpk(y2[2], y2[3]);
                        *(u32x4*)(Qf + (size_t)row * 1536 + h * 192 + 128 + 8 * j) = w;
                    }
                } else {
                    if (wc == 0 && fq == 0) rstdL[rl] = rstd;
                    const float f = s * rstd;
                    { const f32x4 v0 = acc[ai][0][m][0] * f * g0, v1 = acc[ai][0][m][1] * f * g1;
                      u32x4 w; w.x = cvtpk(v0[0], v0[1]); w.y = cvtpk(v0[2], v0[3]); w.z = cvtpk(v1[0], v1[1]); w.w = cvtpk(v1[2], v1[3]);
                      *(u32x4*)(Kf + (size_t)row * 1536 + h * 192 + c0) = w; }
                    { const f32x4 v0 = acc[ai][1][m][0] * s, v1 = acc[ai][1][m][1] * s;
                      u32x4 w; w.x = cvtpk(v0[0], v0[1]); w.y = cvtpk(v0[2], v0[3]); w.z = cvtpk(v1[0], v1[1]); w.w = cvtpk(v1[2], v1[3]);
                      *(u32x4*)(Vf + (size_t)row * 1024 + h * 128 + c0) = w; }
                }
                __builtin_amdgcn_sched_barrier(0);
            }
        if (!isq) {
            LDS_WAIT(); PG8_BAR;
            int tid = fr + 16 * fq + 64 * (wr * 4 + wc);
            const int rl = tid >> 1, jj0 = (tid & 1) * 4, row = u.pm * 256 + rl, pos = row & (S - 1);
            const float rstd = rstdL[rl];
            const bf16_t* kr = P + (size_t)row * NP + PC_KR;
#pragma unroll
            for (int jj = 0; jj < 4; ++jj) {
                const int j2 = jj0 + jj;
                const u32x2 a = *(const u32x2*)(kr + 4 * j2), b = *(const u32x2*)(kr + 32 + 4 * j2);
                const f32x4 ga = *(const f32x4*)(kn_g + 128 + 4 * j2), gb = *(const f32x4*)(kn_g + 160 + 4 * j2);
                const f32x4 cs = *(const f32x4*)(rope + pos * 32 + 4 * j2), sn = *(const f32x4*)(rope + S * 32 + pos * 32 + 4 * j2);
                const f32x4 x1 = (f32x4){bflo(a.x), bfhi(a.x), bflo(a.y), bfhi(a.y)} * rstd * ga, x2 = (f32x4){bflo(b.x), bfhi(b.x), bflo(b.y), bfhi(b.y)} * rstd * gb;
                const f32x4 y1 = x1 * cs - x2 * sn, y2 = x1 * sn + x2 * cs;
                u32x4 w; w.x = cvtpk(y1[0], y1[1]); w.y = cvtpk(y1[2], y1[3]); w.z = cvtpk(y2[0], y2[1]); w.w = cvtpk(y2[2], y2[3]);
                *(u32x4*)(Kf + (size_t)row * 1536 + h * 192 + 128 + 8 * j2) = w;
            }
        }
    }
};

struct EpiD {
    static constexpr bool HAS_MID = true;
    static constexpr float GMIN = 1e-5f;
    bf16_t* Mb; const bf16_t* P;
    __device__ __forceinline__ void mid(f32x4 (&acc)[2][2][4][2], const GUnit& u, int t, int wr, int wc, int fr, int fq) const {
        const int from = (t == 8) ? 0 : 1; const int row0 = u.pm * 256 + wr * 64 + fr;
        const int col0 = u.pn * 256 + wc * 32 + 8 * fq;
#pragma unroll
        for (int ai = 0; ai < 2; ++ai) {
            u32x4 ga[4][2], gb[4][2];
#pragma unroll
            for (int m = 0; m < 4; ++m)
#pragma unroll
                for (int bj = 0; bj < 2; ++bj) {
                    const bf16_t* gp = P + (size_t)(row0 + ai * 128 + m * 16) * NP + PC_GATE + from * 2048 + col0 + bj * 128;
                    ga[m][bj] = *(const u32x4*)gp; gb[m][bj] = *(const u32x4*)(gp + 2048);
                }
#pragma unroll
            for (int m = 0; m < 4; ++m)
#pragma unroll
                for (int bj = 0; bj < 2; ++bj) {
                    const u32x4 a_ = ga[m][bj], b_ = gb[m][bj];
                    f32x4 r0, r1;
                    r0[0] = fmaxf(bflo(a_.x), GMIN) * __builtin_amdgcn_rcpf(fmaxf(bflo(b_.x), GMIN)); r0[1] = fmaxf(bfhi(a_.x), GMIN) * __builtin_amdgcn_rcpf(fmaxf(bfhi(b_.x), GMIN));
                    r0[2] = fmaxf(bflo(a_.y), GMIN) * __builtin_amdgcn_rcpf(fmaxf(bflo(b_.y), GMIN)); r0[3] = fmaxf(bfhi(a_.y), GMIN) * __builtin_amdgcn_rcpf(fmaxf(bfhi(b_.y), GMIN));
                    r1[0] = fmaxf(bflo(a_.z), GMIN) * __builtin_amdgcn_rcpf(fmaxf(bflo(b_.z), GMIN)); r1[1] = fmaxf(bfhi(a_.z), GMIN) * __builtin_amdgcn_rcpf(fmaxf(bfhi(b_.z), GMIN));
                    r1[2] = fmaxf(bflo(a_.w), GMIN) * __builtin_amdgcn_rcpf(fmaxf(bflo(b_.w), GMIN)); r1[3] = fmaxf(bfhi(a_.w), GMIN) * __builtin_amdgcn_rcpf(fmaxf(bfhi(b_.w), GMIN));
                    acc[ai][bj][m][0] *= r0; acc[ai][bj][m][1] *= r1;
                }
            __builtin_amdgcn_sched_barrier(0);
        }
    }
    __device__ __forceinline__ void operator()(const f32x4 (&acc)[2][2][4][2], const GUnit& u, int wr, int wc, int fr, int fq) const {
        const int row0 = u.pm * 256 + wr * 64 + fr;
#pragma unroll
        for (int ai = 0; ai < 2; ++ai)
#pragma unroll
            for (int m = 0; m < 4; ++m) {
                const int row = row0 + ai * 128 + m * 16;
#pragma unroll
                for (int bj = 0; bj < 2; ++bj) {
                    const int col = u.pn * 256 + bj * 128 + wc * 32 + 8 * fq;
                    const u32x4 g = *(const u32x4*)(P + (size_t)row * NP + PC_GATE + 2 * 2048 + col);
                    const f32x4 v0 = acc[ai][bj][m][0] * (f32x4){fmaxf(bflo(g.x), GMIN), fmaxf(bfhi(g.x), GMIN), fmaxf(bflo(g.y), GMIN), fmaxf(bfhi(g.y), GMIN)};
                    const f32x4 v1 = acc[ai][bj][m][1] * (f32x4){fmaxf(bflo(g.z), GMIN), fmaxf(bfhi(g.z), GMIN), fmaxf(bflo(g.w), GMIN), fmaxf(bfhi(g.w), GMIN)};
                    u32x4 w; w.x = cvtpk(v0[0], v0[1]); w.y = cvtpk(v0[2], v0[3]); w.z = cvtpk(v1[0], v1[1]); w.w = cvtpk(v1[2], v1[3]);
                    *(u32x4*)(Mb + (size_t)row * DM + col) = w;
                }
            }
    }
};

struct EpiE {
    static constexpr bool HAS_MID = false;
    const float* xin; float* xout; bf16_t* xb; float* ssq; bool dry;
    __device__ __forceinline__ void operator()(const f32x4 (&acc)[2][2][4][2], const GUnit& u, int wr, int wc, int fr, int fq) const {
        const int row0 = u.pm * 256 + wr * 64 + fr;
#pragma unroll
        for (int ai = 0; ai < 2; ++ai)
#pragma unroll
            for (int m = 0; m < 4; ++m) {
                const int row = row0 + ai * 128 + m * 16; float sq = 0.f;
#pragma unroll
                for (int bj = 0; bj < 2; ++bj) {
                    const int col = u.pn * 256 + bj * 128 + wc * 32 + 8 * fq;
                    const float* xp = xin + (size_t)row * DM + col;
                    const f32x4 v0 = acc[ai][bj][m][0] + *(const f32x4*)xp, v1 = acc[ai][bj][m][1] + *(const f32x4*)(xp + 4);
                    float* op = xout + (size_t)row * DM + col;
                    *(f32x4*)op = v0; *(f32x4*)(op + 4) = v1;
                    if (ssq) {
                        sq += (v0[0] * v0[0] + v0[1] * v0[1]) + (v0[2] * v0[2] + v0[3] * v0[3]) + (v1[0] * v1[0] + v1[1] * v1[1]) + (v1[2] * v1[2] + v1[3] * v1[3]);
                        u32x4 w; w.x = cvtpk(v0[0], v0[1]); w.y = cvtpk(v0[2], v0[3]); w.z = cvtpk(v1[0], v1[1]); w.w = cvtpk(v1[2], v1[3]);
                        *(u32x4*)(xb + (size_t)row * DM + col) = w;
                    }
                }
                if (ssq && !dry) { sq += __shfl_xor(sq, 16); sq += __shfl_xor(sq, 32); if (fq == 0) atomicAdd(ssq + row, sq); }
            }
    }
};

__device__ __forceinline__ int tr_srcmap(int kind, int n);
__device__ __forceinline__ void transpose_one(const float* W, int ldw, int Ndst, bf16_t* WT, int ldd, int kofs, const float* kscale, int kind,
                                              LAS float* scr, int it, int lane) {
    const int nblk = Ndst / 32;
    const int kb = it / nblk, nb = it % nblk, k0 = 64 * kb, n0 = 32 * nb;
    const int sc = tr_srcmap(kind, n0 + (lane & 31));
    float tv[32];
    const float* wp = W + (size_t)(k0 + (lane >> 5)) * ldw + (sc >= 0 ? sc : 0);
#pragma unroll
    for (int i = 0; i < 32; ++i) tv[i] = __builtin_nontemporal_load(wp + (size_t)(2 * i) * ldw);
    if (kscale) {
#pragma unroll
        for (int i = 0; i < 32; ++i) tv[i] *= kscale[k0 + 2 * i + (lane >> 5)];
    }
#pragma unroll
    for (int i = 0; i < 32; ++i) scr[(2 * i + (lane >> 5)) * 33 + (lane & 31)] = (sc >= 0) ? tv[i] : 0.f;
    LDS_WAIT(); asm volatile("" ::: "memory");
    const int c = lane & 7;
#pragma unroll
    for (int j = 0; j < 4; ++j) { const int n = (lane >> 3) + 8 * j; const LAS float* s = scr + (8 * c) * 33 + n;
        u32x4 o; o.x = pk2(s[0 * 33], s[1 * 33]); o.y = pk2(s[2 * 33], s[3 * 33]); o.z = pk2(s[4 * 33], s[5 * 33]); o.w = pk2(s[6 * 33], s[7 * 33]);
        *(u32x4*)(WT + (size_t)(n0 + n) * ldd + kofs + k0 + 8 * c) = o; }
    LDS_WAIT(); asm volatile("" ::: "memory");
}
struct MapId { __device__ __forceinline__ int operator()(int n) const { return n; } };
struct MapIn { __device__ __forceinline__ int operator()(int n) const {
    if (n < 3072) return n;
    if (n < 3328) return (n - 3072 < 64) ? n : -1;
    if (n < 4352) return n - 3328 + 3136;
    if (n < 5888) return n - 4352 + 4160;
    if (n < 6144) return (n - 5888 < 128) ? 5696 + (n - 5888) : -1;
    if (n < 6656) return n - 6144 + 5824;
    return n - 6656 + 6336; } };
struct MapUq { __device__ __forceinline__ int operator()(int n) const {
    const int h = n >> 8, p = n & 255;
    if (p < 128) return h * 192 + p;
    if (p < 192) { const int j = (p - 128) >> 3, e = (p - 128) & 7; return h * 192 + 128 + (e >> 2) * 32 + 4 * j + (e & 3); }
    return -1; } };

__device__ __forceinline__ int tr_srcmap(int kind, int n) { return kind == 1 ? MapIn()(n) : (kind == 2 ? MapUq()(n) : n); }

__device__ __forceinline__ void sincos_acc(float ang, float& sn, float& cs) {
    const double x = (double)ang;
    const double rev = x * 0.15915494309189535;
    const double fr = rev - __builtin_rint(rev);
    const double r = fr * 6.283185307179586476925;
    const double r2 = r * r;
    double ts = 1.0, ss = 1.0, tc = 1.0, sc2 = 1.0;
#pragma unroll
    for (int k = 1; k <= 13; ++k) { tc = -tc * r2 * (1.0 / (double)((2 * k - 1) * (2 * k))); sc2 += tc; ts = -ts * r2 * (1.0 / (double)((2 * k) * (2 * k + 1))); ss += ts; }
    sn = (float)(r * ss); cs = (float)sc2;
}

__device__ __forceinline__ int crow(int r, int hi) { return (r & 3) + 8 * (r >> 2) + 4 * hi; }
__device__ __forceinline__ int v_st(int k, int c) { const int kk = (k & ~0xC) | ((k & 4) << 1) | ((k & 8) >> 1); return ((kk >> 3) * 4 + (c >> 5)) * 512 + ((kk & 7) * 32 + (c & 31)) * 2; }
__device__ __forceinline__ int v_rd_base(int lane) { return ((lane & 3) << 3) | (((lane >> 2) & 3) << 6) | (((lane >> 4) & 1) << 5) | (((lane >> 5) & 1) << 8); }
constexpr int v_rd_off(int d0, int ks, int half) { return d0 * 512 + ks * 4096 + half * 2048; }
template <int OFF> __device__ __forceinline__ s16x4 tr_read(int vb) {
    s16x4 r; asm volatile("ds_read_b64_tr_b16 %0, %1 offset:%2" : "=&v"(r) : "v"(vb), "i"(OFF) : "memory"); return r;
}
template <int D0> __device__ __forceinline__ void pv_one(f32x16& od, int vb, bf16x8 pa0, bf16x8 pa1, bf16x8 pa2, bf16x8 pa3) {
    const s16x4 l0 = tr_read<v_rd_off(D0, 0, 0)>(vb), h0 = tr_read<v_rd_off(D0, 0, 1)>(vb), l1 = tr_read<v_rd_off(D0, 1, 0)>(vb), h1 = tr_read<v_rd_off(D0, 1, 1)>(vb);
    const s16x4 l2 = tr_read<v_rd_off(D0, 2, 0)>(vb), h2 = tr_read<v_rd_off(D0, 2, 1)>(vb), l3 = tr_read<v_rd_off(D0, 3, 0)>(vb), h3 = tr_read<v_rd_off(D0, 3, 1)>(vb);
    asm volatile("s_waitcnt lgkmcnt(0)" ::: "memory"); __builtin_amdgcn_sched_barrier(0);
#define PK(L, H) (bf16x8){L[0], L[1], L[2], L[3], H[0], H[1], H[2], H[3]}
    od = __builtin_amdgcn_mfma_f32_32x32x16_bf16(pa0, PK(l0, h0), od, 0, 0, 0);
    od = __builtin_amdgcn_mfma_f32_32x32x16_bf16(pa1, PK(l1, h1), od, 0, 0, 0);
    od = __builtin_amdgcn_mfma_f32_32x32x16_bf16(pa2, PK(l2, h2), od, 0, 0, 0);
    od = __builtin_amdgcn_mfma_f32_32x32x16_bf16(pa3, PK(l3, h3), od, 0, 0, 0);
#undef PK
}
#define PK4(P, BASE, OUT) do { unsigned a0 = cvtpk(P[BASE + 0], P[BASE + 1]), a1 = cvtpk(P[BASE + 2], P[BASE + 3]);   \
    unsigned b0 = cvtpk(P[BASE + 4], P[BASE + 5]), b1 = cvtpk(P[BASE + 6], P[BASE + 7]);                              \
    auto r0 = __builtin_amdgcn_permlane32_swap(a0, b0, false, false); auto r1 = __builtin_amdgcn_permlane32_swap(a1, b1, false, false); \
    u32x4 w_ = {r0[0], r1[0], r0[1], r1[1]}; OUT = __builtin_bit_cast(bf16x8, w_); } while (0)

__device__ __forceinline__ void sb_block(f32x16& Z, int keyb, int rowi, int hi, float R, float& E) {
#pragma unroll
    for (int g = 3; g >= 0; --g) {
        float lf[4], zz[4]; bool vd[4];
#pragma unroll
        for (int q = 0; q < 4; ++q) {
            const float z = Z[4 * g + q] * SCALE_SB; const bool valid = (keyb + 8 * g + q) < rowi;
            const float sp = fmaxf(z, 0.f) + __logf(1.f + __expf(-fabsf(z)));
            lf[q] = valid ? -sp : 0.f; zz[q] = z; vd[q] = valid;
        }
        const float ex3 = 0.f, ex2 = lf[3], ex1 = ex2 + lf[2], ex0 = ex1 + lf[1], G = ex0 + lf[0];
        const float Gp = __shfl_xor(G, 32);
        const float off = R + E + (hi == 0 ? Gp : 0.f);
        Z[4 * g + 0] = vd[0] ? __expf(zz[0] + lf[0] + off + ex0) : 0.f;
        Z[4 * g + 1] = vd[1] ? __expf(zz[1] + lf[1] + off + ex1) : 0.f;
        Z[4 * g + 2] = vd[2] ? __expf(zz[2] + lf[2] + off + ex2) : 0.f;
        Z[4 * g + 3] = vd[3] ? __expf(zz[3] + lf[3] + off + ex3) : 0.f;
        E += G + Gp;
    }
}

template <int DQK, bool SBM>
__device__ __forceinline__ void attn_unit(LAS unsigned char* lds, const bf16_t* Qp, int ldq, const bf16_t* Kp, int ldk, const bf16_t* Vp, int ldv,
                                          const bf16_t* Gp, int ldg, bf16_t* Op, int ldo, int qb) {
    constexpr int KROW = DQK * 2, KT_BYTES = 64 * KROW, VT_BYTES = 64 * 128 * 2, NKP = DQK / 64, ND0 = DQK / 16, PPR = DQK / 8;
    int tid = threadIdx.x; asm volatile("" : "+v"(tid));
    const int wid = __builtin_amdgcn_readfirstlane(tid >> 6), lane = tid & 63, r32 = lane & 31, hi = lane >> 5;
    LAS unsigned char* Kl = lds; LAS unsigned char* Vl = lds + 3 * KT_BYTES;
    LAS float* wscr = (LAS float*)(lds + LDS_SCR + 9216) + wid * 64;
    LAS int* flags = (LAS int*)(lds + LDS_SCR + 11264);
    bf16x8 qr[ND0];
    { const bf16_t* Qw = Qp + (size_t)(wid * 32 + r32) * ldq + hi * 8;
#pragma unroll
      for (int d0 = 0; d0 < ND0; ++d0) qr[d0] = *(const bf16x8*)(Qw + d0 * 16); }
    f32x16 o[4];
#pragma unroll
    for (int d = 0; d < 4; ++d)
#pragma unroll
        for (int r = 0; r < 16; ++r) o[d][r] = 0.f;
    float m_reg = -1e30f, l_reg = 0.f, R = 0.f;
    const int NT = 4 * qb + 4;
    const int vb0 = (int)(uintptr_t)Vl + v_rd_base(lane);
    int koff[NKP], voff[2];
#pragma unroll
    for (int i = 0; i < NKP; ++i) { const int q = (wid * NKP + i) * 64 + lane, row = q / PPR, c16 = q % PPR; koff[i] = row * ldk + ((c16 ^ (row & 7)) * 8); }
#pragma unroll
    for (int i = 0; i < 2; ++i) { const int q = (wid * 2 + i) * 64 + lane, st = q >> 5, wi = q & 31, kk = (st >> 2) * 8 + (wi >> 2), c = (st & 3) * 32 + (wi & 3) * 8;
        const int k = (kk & ~0xC) | ((kk & 4) << 1) | ((kk & 8) >> 1); voff[i] = k * ldv + c; }
#define ISSUE(kt, b) do { _Pragma("unroll") for (int i = 0; i < NKP; ++i) __builtin_amdgcn_global_load_lds((const unsigned*)(Kp + (size_t)(kt) * 64 * ldk + koff[i]), \
            (LAS unsigned*)(Kl + (b) * KT_BYTES + (wid * NKP + i) * 1024), 16, 0, 0); \
        _Pragma("unroll") for (int i = 0; i < 2; ++i) __builtin_amdgcn_global_load_lds((const unsigned*)(Vp + (size_t)(kt) * 64 * ldv + voff[i]), \
            (LAS unsigned*)(Vl + (b) * VT_BYTES + (wid * 2 + i) * 1024), 16, 0, 0); } while (0)
    ISSUE(SBM ? NT - 1 : 0, 0);
    if (NT > 1) { ISSUE(SBM ? NT - 2 : 1, 1); if constexpr (NKP == 3) asm volatile("s_waitcnt vmcnt(5)" ::: "memory"); else asm volatile("s_waitcnt vmcnt(4)" ::: "memory"); }
    else asm volatile("s_waitcnt vmcnt(0)" ::: "memory");
    __syncthreads();
    const int rowi = 256 * qb + 32 * wid + r32;
    for (int it = 0; it < NT; ++it) {
        const int kt = SBM ? NT - 1 - it : it, buf = it % 3;
        if (it + 2 < NT) ISSUE(SBM ? kt - 2 : kt + 2, (it + 2) % 3);
        const bool active = SBM ? (64 * kt <= 256 * qb + 32 * wid + 30) : (kt <= 4 * qb + (wid >> 1));
        if (active) {
            f32x16 p0, p1;
#pragma unroll
            for (int r = 0; r < 16; ++r) { p0[r] = 0.f; p1[r] = 0.f; }
            LAS unsigned char* Kb = Kl + buf * KT_BYTES;
#pragma unroll
            for (int dl = 0; dl < 4; ++dl) {
                LAS unsigned char* kb_dl = Kb + r32 * KROW + ((dl * 32 + hi * 16) ^ ((r32 & 7) << 4));
#pragma unroll
                for (int dh = 0; dh < ND0 / 4; ++dh) {
                    const bf16x8 b0 = *(const LAS bf16x8*)(kb_dl + dh * 128);
                    const bf16x8 b1 = *(const LAS bf16x8*)(kb_dl + dh * 128 + 32 * KROW);
                    p0 = __builtin_amdgcn_mfma_f32_32x32x16_bf16(b0, qr[4 * dh + dl], p0, 0, 0, 0);
                    p1 = __builtin_amdgcn_mfma_f32_32x32x16_bf16(b1, qr[4 * dh + dl], p1, 0, 0, 0); }
                __builtin_amdgcn_sched_barrier(0); }
            if constexpr (SBM) {
                float E = 0.f;
                sb_block(p1, kt * 64 + 32 + 4 * hi, rowi, hi, R, E);
                sb_block(p0, kt * 64 + 4 * hi, rowi, hi, R, E);
                R += E;
            } else {
                float pmax = p0[0];
#pragma unroll
                for (int r = 1; r < 16; ++r) pmax = fmaxf(pmax, p0[r]);
#pragma unroll
                for (int r = 0; r < 16; ++r) pmax = fmaxf(pmax, p1[r]);
                pmax = fmaxf(pmax, __shfl_xor(pmax, 32));
                float mn = m_reg, alpha = 1.f;
                if (!__all(pmax - m_reg <= 8.f)) { mn = fmaxf(m_reg, pmax); alpha = __builtin_amdgcn_exp2f(m_reg - mn); m_reg = mn; }
                float ps = 0.f;
#pragma unroll
                for (int r = 0; r < 16; ++r) { p0[r] = __builtin_amdgcn_exp2f(p0[r] - mn); ps += p0[r]; }
#pragma unroll
                for (int r = 0; r < 16; ++r) { p1[r] = __builtin_amdgcn_exp2f(p1[r] - mn); ps += p1[r]; }
                ps += __shfl_xor(ps, 32);
                l_reg = l_reg * alpha + ps;
                if (__any(alpha < 1.f)) {
                    if (hi == 0) wscr[r32] = alpha;
                    LDS_WAIT();
#pragma unroll
                    for (int r = 0; r < 16; ++r) { const float al = wscr[crow(r, hi)];
#pragma unroll
                        for (int d = 0; d < 4; ++d) o[d][r] *= al; }
                }
            }
            bf16x8 pa0, pa1, pa2, pa3;
            PK4(p0, 0, pa0); PK4(p0, 8, pa1); PK4(p1, 0, pa2); PK4(p1, 8, pa3);
            const int vb = vb0 + buf * VT_BYTES;
            pv_one<0>(o[0], vb, pa0, pa1, pa2, pa3); pv_one<1>(o[1], vb, pa0, pa1, pa2, pa3); pv_one<2>(o[2], vb, pa0, pa1, pa2, pa3); pv_one<3>(o[3], vb, pa0, pa1, pa2, pa3);
        }
        if constexpr (SBM) { const int dn = __all(R < -104.f) ? 1 : 0; if (lane == 0) flags[(it & 1) * 8 + wid] = dn; }
        if (it + 2 < NT) { if constexpr (NKP == 3) asm volatile("s_waitcnt vmcnt(5)" ::: "memory"); else asm volatile("s_waitcnt vmcnt(4)" ::: "memory"); }
        else asm volatile("s_waitcnt vmcnt(0)" ::: "memory");
        __syncthreads();
        if constexpr (SBM) {
            int alld = 1;
#pragma unroll
            for (int w = 0; w < 8; ++w) alld &= flags[(it & 1) * 8 + w];
            if (alld) { asm volatile("s_waitcnt vmcnt(0)" ::: "memory"); break; }
        }
    }
    if constexpr (SBM) __syncthreads();
    if constexpr (!SBM) { if (hi == 0) wscr[r32] = l_reg; LDS_WAIT(); }
    LAS float* ot = (LAS float*)lds + wid * (32 * 132);
#pragma unroll
    for (int r = 0; r < 16; ++r) { const int orow = crow(r, hi);
        float rl = 1.f; if constexpr (!SBM) rl = __builtin_amdgcn_rcpf(wscr[orow]);
#pragma unroll
        for (int d0 = 0; d0 < 4; ++d0) ot[orow * 132 + d0 * 32 + r32] = o[d0][r] * rl; }
    LDS_WAIT();
    { const int er = lane >> 4, ec = (lane & 15) * 8;
      const bf16_t* Gw = Gp + (size_t)(wid * 32 + er) * ldg + ec; bf16_t* Ow = Op + (size_t)(wid * 32 + er) * ldo + ec;
      u32x4 gv[8];
#pragma unroll
      for (int ps = 0; ps < 8; ++ps) gv[ps] = *(const u32x4*)(Gw + (size_t)(ps * 4) * ldg);
#pragma unroll
      for (int ps = 0; ps < 8; ++ps) {
          const f32x4 a0 = *(const LAS f32x4*)(ot + (ps * 4 + er) * 132 + ec), a1 = *(const LAS f32x4*)(ot + (ps * 4 + er) * 132 + ec + 4);
          const u32x4 g = gv[ps];
          u32x4 w; w.x = cvtpk(a0[0] * bflo(g.x), a0[1] * bfhi(g.x)); w.y = cvtpk(a0[2] * bflo(g.y), a0[3] * bfhi(g.y));
          w.z = cvtpk(a1[0] * bflo(g.z), a1[1] * bfhi(g.z)); w.w = cvtpk(a1[2] * bflo(g.w), a1[3] * bfhi(g.w));
          *(u32x4*)(Ow + (size_t)(ps * 4) * ldo) = w;
          __builtin_amdgcn_sched_barrier(0);
      } }
    __syncthreads();
#undef ISSUE
}

__device__ __forceinline__ float rowsum16(float x) {
    x += __builtin_bit_cast(float, __builtin_amdgcn_update_dpp(0, __builtin_bit_cast(int, x), 0x128, 0xf, 0xf, false));
    x += __builtin_bit_cast(float, __builtin_amdgcn_update_dpp(0, __builtin_bit_cast(int, x), 0x124, 0xf, 0xf, false));
    x += __builtin_bit_cast(float, __builtin_amdgcn_update_dpp(0, __builtin_bit_cast(int, x), 0x122, 0xf, 0xf, false));
    x += __builtin_bit_cast(float, __builtin_amdgcn_update_dpp(0, __builtin_bit_cast(int, x), 0x121, 0xf, 0xf, false));
    return x;
}

__device__ __forceinline__ float wsum64(float x) {
    x = rowsum16(x);
    const int xi = __builtin_bit_cast(int, x);
    const float r0 = __builtin_bit_cast(float, __builtin_amdgcn_readlane(xi, 0)), r1 = __builtin_bit_cast(float, __builtin_amdgcn_readlane(xi, 16));
    const float r2 = __builtin_bit_cast(float, __builtin_amdgcn_readlane(xi, 32)), r3 = __builtin_bit_cast(float, __builtin_amdgcn_readlane(xi, 48));
    return (r0 + r1) + (r2 + r3);
}

template <int NB>
__device__ __forceinline__ void rw_finaliseN(int it0, int stride, const float* gng, const float* gnb, const float* rk, const float* OSC, const float* SCN, const bf16_t* P, bf16_t* ycat) {
    int tl = threadIdx.x; asm volatile("" : "+v"(tl)); const int lane = tl & 63;
    float ov[NB], rr[NB], kk_[NB], vv_[NB], gg[NB];
#pragma unroll
    for (int q = 0; q < NB; ++q) { const int it = it0 + q * stride, t = it >> 3, h = it & 7, b = t >> 12, s = t & (S - 1), ch = h * 64 + lane;
        ov[q] = OSC[(size_t)t * 512 + ch];
        const float* sp = SCN + ((size_t)(b * 8 + h) * S + s) * 384 + lane;
        rr[q] = sp[0]; kk_[q] = sp[128]; vv_[q] = sp[320];
        gg[q] = bf2f(P[(size_t)t * NP + PC_RG + ch]); }
#pragma unroll
    for (int q = 0; q < NB; ++q) { const int it = it0 + q * stride, t = it >> 3, h = it & 7, ch = h * 64 + lane;
        const float mu = wsum64(ov[q]) * (1.f / 64.f), d = ov[q] - mu, var = wsum64(d * d) * (1.f / 64.f);
        const float y = d * rsqrtf(var + 64e-5f) * gng[ch] + gnb[ch];
        const float bonus = wsum64(rr[q] * kk_[q] * rk[ch]) * vv_[q];
        ycat[(size_t)t * DM + 1536 + ch] = (bf16_t)f2bf((y + bonus) * gg[q]); }
}

struct RwParams { const float* PRW; const float* mu; const float* w0; const float* w_up; const float* a0; const float* a_up; const float* k_k; const float* k_a; float* SCN; };

__device__ __forceinline__ void rw_prep(LAS unsigned char* lds, const RwParams& q, int tile) {
    int tid = threadIdx.x; asm volatile("" : "+v"(tid));
    const int lane = tid & 63, h = tid >> 6, t0 = tile * 32;
    LAS float* tw = (LAS float*)lds; LAS float* ta = tw + 2048;
#pragma unroll
    for (int e = 0; e < 8; ++e) { const int idx = tid + 512 * e, tk = idx >> 7, jj = idx & 127, t = t0 + tk;
        const float cur = q.PRW[(size_t)t * PRW_LD + 1536 + jj];
        const float prev = ((t & (S - 1)) == 0) ? 0.f : q.PRW[(size_t)(t - 1) * PRW_LD + 1536 + jj];
        const float sh = cur + q.mu[1536 + jj] * (prev - cur);
        if (jj < 64) tw[tk * 64 + jj] = tanhf(sh); else ta[tk * 64 + jj - 64] = sh; }
    __syncthreads();
    float aw[32], aa[32];
#pragma unroll
    for (int k = 0; k < 32; ++k) { aw[k] = 0.f; aa[k] = 0.f; }
    for (int j0 = 0; j0 < 64; j0 += 4) {
        float wu[4], au[4];
#pragma unroll
        for (int e = 0; e < 4; ++e) { wu[e] = q.w_up[(j0 + e) * 512 + tid]; au[e] = q.a_up[(j0 + e) * 512 + tid]; }
#pragma unroll
        for (int k = 0; k < 32; ++k) { const f32x4 x = *(const LAS f32x4*)(tw + k * 64 + j0), y = *(const LAS f32x4*)(ta + k * 64 + j0);
            aw[k] += (x[0] * wu[0] + x[1] * wu[1]) + (x[2] * wu[2] + x[3] * wu[3]);
            aa[k] += (y[0] * au[0] + y[1] * au[1]) + (y[2] * au[2] + y[3] * au[3]); }
    }
    const float w0c = q.w0[tid], a0c = q.a0[tid], kkc = q.k_k[tid], kac = q.k_a[tid], mur = q.mu[tid], muk = q.mu[512 + tid], muv = q.mu[1024 + tid];
    float pr = 0.f, pk = 0.f, pv = 0.f;
    if ((t0 & (S - 1)) != 0) { const float* pp = q.PRW + (size_t)(t0 - 1) * PRW_LD; pr = pp[tid]; pk = pp[512 + tid]; pv = pp[1024 + tid]; }
    const int b = t0 >> 12, s0 = t0 & (S - 1);
    float* dst = q.SCN + ((size_t)(b * 8 + h) * S + s0) * 384 + lane;
#pragma unroll
    for (int k = 0; k < 32; ++k) {
        const float* cp = q.PRW + (size_t)(t0 + k) * PRW_LD;
        const float cr = cp[tid], ck = cp[512 + tid], cv = cp[1024 + tid];
        const float rs_ = cr + mur * (pr - cr), ks_ = ck + muk * (pk - ck), vs_ = cv + muv * (pv - cv);
        pr = cr; pk = ck; pv = cv;
        const float uu = -(w0c + aw[k]);
        const float spl = fmaxf(uu, 0.f) + log1pf(expf(-fabsf(uu)));
        const float decay = expf(-expf(-spl - 0.5f));
        const float a = 1.f / (1.f + expf(-(a0c + aa[k])));
        float kk = ks_ * kkc; const float n2 = wsum64(kk * kk); kk = kk / fmaxf(sqrtf(n2), 1e-12f);
        const float kmod = ks_ * (1.f + (a - 1.f) * kac);
        float* d = dst + (size_t)k * 384;
        d[0] = rs_; d[64] = decay; d[128] = kmod; d[192] = -kk; d[256] = kk * a; d[320] = vs_;
    }
    __syncthreads();
}

__device__ __forceinline__ void rw_prep_mfma(LAS unsigned char* lds, const RwParams& q, int tile) {
    int tid = threadIdx.x; asm volatile("" : "+v"(tid));
    const int lane = tid & 63, h = __builtin_amdgcn_readfirstlane(tid >> 6), t0 = tile * 32, l16 = lane & 15, lq = lane >> 4;
    constexpr int TS = 65;
    LAS float* tw = (LAS float*)lds; LAS float* ta = tw + 32 * TS;
#pragma unroll
    for (int e = 0; e < 8; ++e) { const int idx = tid + 512 * e, tk = idx >> 7, jj = idx & 127, t = t0 + tk;
        const float cur = q.PRW[(size_t)t * PRW_LD + 1536 + jj];
        const float prev = ((t & (S - 1)) == 0) ? 0.f : q.PRW[(size_t)(t - 1) * PRW_LD + 1536 + jj];
        const float sh = cur + q.mu[1536 + jj] * (prev - cur);
        if (jj < 64) { const float e2 = __expf(-2.f * fabsf(sh)), th = (1.f - e2) * __builtin_amdgcn_rcpf(1.f + e2); tw[tk * TS + jj] = sh < 0.f ? -th : th; }
        else ta[tk * TS + jj - 64] = sh; }
    __syncthreads();
    f32x4 accW[2][4], accA[2][4];
#pragma unroll
    for (int tb = 0; tb < 2; ++tb)
#pragma unroll
        for (int cb = 0; cb < 4; ++cb) { accW[tb][cb] = (f32x4){0.f, 0.f, 0.f, 0.f}; accA[tb][cb] = (f32x4){0.f, 0.f, 0.f, 0.f}; }
    const float* wu = q.w_up + h * 64 + l16; const float* au = q.a_up + h * 64 + l16;
#pragma unroll 2
    for (int ks = 0; ks < 16; ++ks) {
        const int kk = 4 * ks + lq;
        float aW[2], aA[2], bW[4], bA[4];
#pragma unroll
        for (int tb = 0; tb < 2; ++tb) { aW[tb] = tw[(tb * 16 + l16) * TS + kk]; aA[tb] = ta[(tb * 16 + l16) * TS + kk]; }
#pragma unroll
        for (int cb = 0; cb < 4; ++cb) { bW[cb] = wu[kk * 512 + cb * 16]; bA[cb] = au[kk * 512 + cb * 16]; }
#pragma unroll
        for (int tb = 0; tb < 2; ++tb)
#pragma unroll
            for (int cb = 0; cb < 4; ++cb) { accW[tb][cb] = __builtin_amdgcn_mfma_f32_16x16x4f32(aW[tb], bW[cb], accW[tb][cb], 0, 0, 0);
                                             accA[tb][cb] = __builtin_amdgcn_mfma_f32_16x16x4f32(aA[tb], bA[cb], accA[tb][cb], 0, 0, 0); }
    }
    const int b = t0 >> 12, s0 = t0 & (S - 1);
#pragma unroll
    for (int tb = 0; tb < 2; ++tb) {
        const int tkb = tb * 16 + 4 * lq;
        const bool first = (((t0 + tkb) & (S - 1)) == 0);
        float kkv[4][4], av[4][4];
#pragma unroll
        for (int cb = 0; cb < 4; ++cb) {
            const int c = h * 64 + cb * 16 + l16;
            const float w0c = q.w0[c], a0c = q.a0[c], kkc = q.k_k[c], kac = q.k_a[c], mur = q.mu[c], muk = q.mu[512 + c], muv = q.mu[1024 + c];
            float pr = 0.f, pk = 0.f, pv = 0.f;
            if (!first) { const float* pp = q.PRW + (size_t)(t0 + tkb - 1) * PRW_LD; pr = pp[c]; pk = pp[512 + c]; pv = pp[1024 + c]; }
#pragma unroll
            for (int r = 0; r < 4; ++r) {
                const float* cp = q.PRW + (size_t)(t0 + tkb + r) * PRW_LD;
                const float cr = cp[c], ck = cp[512 + c], cv = cp[1024 + c];
                const float rs_ = cr + mur * (pr - cr), ks_ = ck + muk * (pk - ck), vs_ = cv + muv * (pv - cv);
                pr = cr; pk = ck; pv = cv;
                const float uu = -(w0c + accW[tb][cb][r]);
                const float spl = fmaxf(uu, 0.f) + __logf(1.f + __expf(-fabsf(uu)));
                const float decay = __expf(-__expf(-spl - 0.5f));
                const float a = __builtin_amdgcn_rcpf(1.f + __expf(-(a0c + accA[tb][cb][r])));
                kkv[cb][r] = ks_ * kkc; av[cb][r] = a;
                float* d = q.SCN + ((size_t)(b * 8 + h) * S + s0 + tkb + r) * 384 + cb * 16 + l16;
                d[0] = rs_; d[64] = decay; d[128] = ks_ * (1.f + (a - 1.f) * kac); d[320] = vs_;
            }
        }
#pragma unroll
        for (int r = 0; r < 4; ++r) {
            float n2 = (kkv[0][r] * kkv[0][r] + kkv[1][r] * kkv[1][r]) + (kkv[2][r] * kkv[2][r] + kkv[3][r] * kkv[3][r]);
            n2 = rowsum16(n2);
            const float inv = __builtin_amdgcn_rsqf(fmaxf(n2, 1e-24f));
            float* d = q.SCN + ((size_t)(b * 8 + h) * S + s0 + tkb + r) * 384 + l16;
#pragma unroll
            for (int cb = 0; cb < 4; ++cb) { const float kn = kkv[cb][r] * inv; d[192 + cb * 16] = -kn; d[256 + cb * 16] = kn * av[cb][r]; }
        }
    }
    __syncthreads();
}

__device__ __forceinline__ void rw_scan(LAS unsigned char* lds, const float* SCN, float* OSC, int sb) {
    int tid = threadIdx.x; asm volatile("" : "+v"(tid));
    const int wid = __builtin_amdgcn_readfirstlane(tid >> 6), lane = tid & 63;
    const int bh = sb >> 2, rg = sb & 3, b = bh >> 3, h = bh & 7;
    const float* src = SCN + (size_t)bh * S * 384;
    constexpr int CH = 16, CHF = CH * 384, NCH = S / CH;
    LAS float* bufs = (LAS float*)lds;
    LAS float* pb = bufs + 4 * CHF;
    const int rowl = 4 * wid + (lane >> 4), cg4 = (lane & 15) * 4;
    f32x4 s = (f32x4){0.f, 0.f, 0.f, 0.f};
#define SCAN_ISSUE(ch) do { const float* sp_ = src + (size_t)(ch) * CHF + lane * 4; LAS float* dp_ = bufs + ((ch) & 3) * CHF; \
        _Pragma("unroll") for (int i = 0; i < 12; ++i) { const int j = (wid - 4) * 12 + i; \
            __builtin_amdgcn_global_load_lds((const unsigned*)(sp_ + j * 256), (LAS unsigned*)(dp_ + j * 256), 16, 0, 0); } } while (0)
    if (wid == 4 || wid == 5) { SCAN_ISSUE(0); SCAN_ISSUE(1); SCAN_ISSUE(2); asm volatile("s_waitcnt vmcnt(24)" ::: "memory"); }
    __syncthreads();
    for (int c = 0; c < NCH; ++c) {
        if (wid < 4) {
            const LAS float* bp = bufs + (c & 3) * CHF + cg4;
            const LAS float* vp = bufs + (c & 3) * CHF + 320 + 16 * rg + rowl;
            LAS float* pp = pb + (c & 1) * 4096 + wid * 64 + lane;
            f32x4 r4[3], w4[3], k4[3], a4[3], b4[3]; float vv[3];
            const unsigned ba = (unsigned)(uintptr_t)bp, va = (unsigned)(uintptr_t)vp;
#define LRD128(dst, addr, off) asm volatile("ds_read_b128 %0, %1 offset:%2" : "=v"(dst) : "v"(addr), "i"(off))
#define LRD32(dst, addr, off) asm volatile("ds_read_b32 %0, %1 offset:%2" : "=v"(dst) : "v"(addr), "i"(off))
#define RD_STEP(set, stp) do { LRD128(r4[set], ba, (stp) * 1536); LRD128(w4[set], ba, (stp) * 1536 + 256); LRD128(k4[set], ba, (stp) * 1536 + 512); \
        LRD128(a4[set], ba, (stp) * 1536 + 768); LRD128(b4[set], ba, (stp) * 1536 + 1024); LRD32(vv[set], va, (stp) * 1536); } while (0)
#define WAITK(n, set) asm volatile("s_waitcnt lgkmcnt(" #n ")" : "+v"(r4[set]), "+v"(w4[set]), "+v"(k4[set]), "+v"(a4[set]), "+v"(b4[set]), "+v"(vv[set]))
#define STEP_BODY(st, cu) do { const f32x4 sa4 = s * a4[cu]; float sa = (sa4[0] + sa4[1]) + (sa4[2] + sa4[3]); \
        const f32x4 t1 = s * w4[cu] + vv[cu] * k4[cu]; sa = rowsum16(sa); s = t1 + sa * b4[cu]; \
        const f32x4 o4 = s * r4[cu]; pp[(st) * 256] = (o4[0] + o4[1]) + (o4[2] + o4[3]); } while (0)
#define STEP(st) do { RD_STEP(((st) + 2) % 3, (st) + 2); WAITK(12, (st) % 3); STEP_BODY(st, (st) % 3); } while (0)
            RD_STEP(0, 0); RD_STEP(1, 1);
            STEP(0); STEP(1); STEP(2); STEP(3); STEP(4); STEP(5); STEP(6); STEP(7); STEP(8); STEP(9); STEP(10); STEP(11); STEP(12); STEP(13);
            WAITK(6, 14 % 3); STEP_BODY(14, 14 % 3);
            WAITK(0, 15 % 3); STEP_BODY(15, 15 % 3);
#undef STEP
#undef STEP_BODY
#undef WAITK
#undef RD_STEP
#undef LRD32
#undef LRD128
        } else if (wid < 6) {
            if (c + 3 < NCH) { SCAN_ISSUE(c + 3); asm volatile("s_waitcnt vmcnt(24)" ::: "memory"); }
            else if (c + 2 < NCH) asm volatile("s_waitcnt vmcnt(12)" ::: "memory");
            else asm volatile("s_waitcnt vmcnt(0)" ::: "memory");
        } else if (c > 0) {
            const int lt = tid - 384;
#pragma unroll
            for (int e = 0; e < 2; ++e) { const int oi = lt * 2 + e, st = oi >> 4, rl = oi & 15;
                const LAS f32x4* p4 = (const LAS f32x4*)(pb + ((c - 1) & 1) * 4096 + oi * 16);
                const f32x4 x0 = p4[0], x1 = p4[1], x2 = p4[2], x3 = p4[3];
                const f32x4 t = (x0 + x1) + (x2 + x3);
                OSC[((size_t)b * S + (c - 1) * CH + st) * 512 + h * 64 + 16 * rg + rl] = (t[0] + t[1]) + (t[2] + t[3]); }
        }
        asm volatile("s_waitcnt lgkmcnt(0)" ::: "memory"); __builtin_amdgcn_s_barrier(); asm volatile("" ::: "memory");
    }
    if (wid >= 6) { const int lt = tid - 384;
#pragma unroll
        for (int e = 0; e < 2; ++e) { const int oi = lt * 2 + e, st = oi >> 4, rl = oi & 15;
            const LAS f32x4* p4 = (const LAS f32x4*)(pb + ((NCH - 1) & 1) * 4096 + oi * 16);
            const f32x4 x0 = p4[0], x1 = p4[1], x2 = p4[2], x3 = p4[3];
            const f32x4 t = (x0 + x1) + (x2 + x3);
            OSC[((size_t)b * S + (NCH - 1) * CH + st) * 512 + h * 64 + 16 * rg + rl] = (t[0] + t[1]) + (t[2] + t[3]); } }
    __syncthreads();
#undef SCAN_ISSUE
}

#ifndef PHMASK
#define PHMASK 127
#endif
#ifndef DUPMASK
#define DUPMASK 0
#endif

struct Args { const float* in[23]; float* out; unsigned char* ws; int ph_lo, ph_hi; };

__global__ void __launch_bounds__(512) fwd(Args a) {
    extern __shared__ __attribute__((aligned(16))) unsigned char lds_raw[];
    LAS unsigned char* lds = (LAS unsigned char*)lds_raw;
    cg::grid_group grid = cg::this_grid();
    const int tid = threadIdx.x, lane = tid & 63, wave = __builtin_amdgcn_readfirstlane(tid >> 6);
    const int G = gridDim.x, bx = blockIdx.x, vc = vblock(bx, G);
    const int gw = bx * 8 + wave, ngw = G * 8;
    unsigned char* ws = a.ws;
    float* ctl = (float*)(ws + WS_CTL);
    float* rope = (float*)(ws + WS_ROPE);
    bf16_t* xb = (bf16_t*)(ws + WS_XB); bf16_t* P = (bf16_t*)(ws + WS_P); float* PRW = (float*)(ws + WS_PRW);
    bf16_t* Qf = (bf16_t*)(ws + WS_QF); bf16_t* Kf = (bf16_t*)(ws + WS_KF); bf16_t* Vf = (bf16_t*)(ws + WS_VF);
    float* SCN = (float*)(ws + WS_SCN); float* OSC = (float*)(ws + WS_OSC); bf16_t* ycat = (bf16_t*)(ws + WS_YCAT);
    float* M32 = (float*)(ws + WS_MRG32); bf16_t* Mb = (bf16_t*)(ws + WS_MRGB);
    const float* x_in = a.in[0];
    int ph = 0;
#define PH_ON() (ph >= a.ph_lo && ph < a.ph_hi)
    volatile LAS unsigned* xb_st = (volatile LAS unsigned*)(lds + LDS_BYTES - 16);
    if (tid < 4) xb_st[tid] = 0u;
    __syncthreads();
    XcdBarrier xbar = xcd_barrier_post((unsigned*)(ws + WS_CTL) + CTL_QUEUE + 32768, xb_st);
#define GBAR() xcd_barrier(xbar)
    if (a.ph_lo < 0) grid.sync();
#define SEAM() do { if (ph + 1 > a.ph_lo && ph + 1 < a.ph_hi) { GBAR(); } ++ph; } while (0)

    for (int rep = 0; rep < (((DUPMASK) & 1) ? 2 : 1); ++rep) { if (rep) GBAR(); if (PH_ON() && (PHMASK & 1)) {
        LAS float* scr = (LAS float*)(lds + wave * 8704);
        {
            constexpr int I_IN = 32 * 400, I_UQ = 8 * 64, I_UKV = 8 * 64, I_SB = 8 * 64, I_MLA = 16 * 64, I_RW = 8 * 64, I_OUT = 32 * 64;
            constexpr int I_LAYER = I_IN + I_UQ + I_UKV + I_SB + I_MLA + I_RW + I_OUT;
            for (int it = gw; it < 2 * I_LAYER; it += ngw) {
                const int l = it >= I_LAYER; int r = it - l * I_LAYER;
                bf16_t* wbr = (bf16_t*)(ws + WS_WBR) + (size_t)l * DM * DM;
                if (r < I_IN) { transpose_one(a.in[2] + (size_t)l * DM * 12480, 12480, NP, (bf16_t*)(ws + WS_WIN) + (size_t)l * NP * DM, DM, 0, a.in[1] + l * DM, 1, scr, r, lane); continue; } r -= I_IN;
                if (r < I_OUT) { transpose_one(a.in[22] + (size_t)l * DM * DM, DM, DM, (bf16_t*)(ws + WS_WOUT) + (size_t)l * DM * DM, DM, 0, nullptr, 0, scr, r, lane); continue; } r -= I_OUT;
                if (r < I_MLA) { transpose_one(a.in[20] + (size_t)l * 1024 * DM, DM, DM, wbr, DM, 512, nullptr, 0, scr, r, lane); continue; } r -= I_MLA;
                if (r < I_UQ) { transpose_one(a.in[5] + (size_t)l * 512 * 1536, 1536, 2048, (bf16_t*)(ws + WS_WUQ) + (size_t)l * 2048 * 512, 512, 0, a.in[3] + l * 512, 2, scr, r, lane); continue; } r -= I_UQ;
                if (r < I_UKV) { transpose_one(a.in[6] + (size_t)l * 512 * 2048, 2048, 2048, (bf16_t*)(ws + WS_WUKV) + (size_t)l * 2048 * 512, 512, 0, a.in[4] + l * 512, 0, scr, r, lane); continue; } r -= I_UKV;
                if (r < I_SB) { transpose_one(a.in[19] + (size_t)l * 512 * DM, DM, DM, wbr, DM, 0, nullptr, 0, scr, r, lane); continue; } r -= I_SB;
                transpose_one(a.in[21] + (size_t)l * 512 * DM, DM, DM, wbr, DM, 1536, nullptr, 0, scr, r, lane);
            }
        }
        for (int m = gw; m < T; m += ngw) {
            const f32x4* xr = (const f32x4*)(x_in + (size_t)m * DM) + lane; float sq = 0.f;
            u32x2* o8 = (u32x2*)(xb + (size_t)m * DM) + lane;
#pragma unroll
            for (int j = 0; j < 8; ++j) { const f32x4 v = __builtin_nontemporal_load(xr + 64 * j); sq += (v[0] * v[0] + v[1] * v[1]) + (v[2] * v[2] + v[3] * v[3]);
                u32x2 w; w.x = pk2(v[0], v[1]); w.y = pk2(v[2], v[3]); o8[64 * j] = w; }
            sq = wave_sum(sq);
            if (lane == 0) ctl[CTL_SSQX + m] = sq;
        }
        for (int e = bx * 512 + tid; e < S * 32; e += G * 512) {
            const int pos = e >> 5, i = e & 31;
            double f = 1.0; for (int k = 0; k < i; ++k) f *= 0.7498942093324559;
            const float ff = (float)f, ang = (float)pos * ff;
            float sn, cs; sincos_acc(ang, sn, cs);
            rope[e] = cs; rope[S * 32 + e] = sn;
        }
    } }
    SEAM();

    for (int l = 0; l < 2; ++l) {
        float* ssqx = ctl + CTL_SSQX + l * T; float* ssq_cq = ctl + CTL_SSQCQ + l * T; float* ssq_ckv = ctl + CTL_SSQCKV + l * T; float* ssq_kr = ctl + CTL_SSQKR + l * T;
        if (PH_ON()) {
            SchedA1 Sd{(const char*)xb, (const char*)((bf16_t*)(ws + WS_WIN) + (size_t)l * NP * DM), G, vc, (G == 256) ? 32 : 0};
            EpiA E{P, PRW, ssqx, ssq_cq, ssq_ckv, ssq_kr};
            pg8::gemm_phase(lds, DM, DM, Sd, E);
        }
        SEAM();
        if (PH_ON()) {
            RwParams rp{PRW, a.in[9] + l * 1664, a.in[10] + l * 512, a.in[11] + (size_t)l * 64 * 512, a.in[12] + l * 512, a.in[13] + (size_t)l * 64 * 512,
                        a.in[14] + l * 512, a.in[15] + l * 512, SCN};
            for (int tile = bx; tile < 256; tile += G) rw_prep_mfma(lds, rp, tile);
        }
        SEAM();
        for (int rep = 0; rep < 1; ++rep) { if (PH_ON()) {
            const int nscan = (G == 256) ? 64 : 0;
            constexpr int A2_MAIN = 43 * 32 - 32;
            unsigned* sbar = (unsigned*)(ws + WS_CTL) + CTL_QUEUE + 2048;
            const unsigned nsub = (unsigned)(G - nscan);
            if (bx < nscan) {
                rw_scan(lds, SCN, OSC, ((bx & 15) << 2) | (bx >> 4));
                {
                    const int bh = bx & 15, rgq = bx >> 4, hb = bh >> 3, hh = bh & 7;
                    grid_bar((unsigned*)(ws + WS_CTL) + CTL_QUEUE + 4096 + 64 * bh, 4u * (unsigned)(l + 1));
                    if (tid == 0) { while (__hip_atomic_load(sbar, __ATOMIC_RELAXED, __HIP_MEMORY_SCOPE_AGENT) < nsub * (unsigned)(2 * l + 1)) __builtin_amdgcn_s_sleep(8);
                                    __builtin_amdgcn_fence(__ATOMIC_ACQUIRE, "agent"); asm volatile("s_waitcnt vmcnt(0)" ::: "memory"); }
                    __syncthreads();
                    {
                        int tl = threadIdx.x; asm volatile("" : "+v"(tl)); const int ln = tl & 63, ch = hh * 64 + ln;
                        const float gng_c = a.in[17][l * 512 + ch], gnb_c = a.in[18][l * 512 + ch], rk_c = a.in[16][l * 512 + ch];
                        const size_t tq0 = (size_t)hb * S + 1024 * rgq;
                        const float* osc_b = OSC + tq0 * 512 + ch; const float* scn_b = SCN + ((size_t)bh * S + 1024 * rgq) * 384 + ln;
                        const bf16_t* g_b = P + tq0 * NP + PC_RG + ch; bf16_t* y_b = ycat + tq0 * DM + 1536 + ch;
                        float ov0[8], rr0[8], kk0[8], vv0[8], gg0[8], ov1[8], rr1[8], kk1[8], vv1[8], gg1[8];
#define FIN_LOAD(OV, RR, KK, VV, GG, tok) do { _Pragma("unroll") for (int q = 0; q < 8; ++q) { const size_t t_ = (size_t)((tok) + q); \
        OV[q] = osc_b[t_ * 512]; RR[q] = scn_b[t_ * 384]; KK[q] = scn_b[t_ * 384 + 128]; VV[q] = scn_b[t_ * 384 + 320]; GG[q] = bf2f(g_b[t_ * NP]); } } while (0)
#define FIN_COMP(OV, RR, KK, VV, GG, tok) do { _Pragma("unroll") for (int q = 0; q < 8; ++q) { \
        const float mu = wsum64(OV[q]) * (1.f / 64.f), d = OV[q] - mu, var = wsum64(d * d) * (1.f / 64.f); \
        const float y = d * __builtin_amdgcn_rsqf(var + 64e-5f) * gng_c + gnb_c; \
        const float bonus = wsum64(RR[q] * KK[q] * rk_c) * VV[q]; \
        y_b[(size_t)((tok) + q) * DM] = (bf16_t)(cvtpk((y + bonus) * GG[q], 0.f) & 0xffffu); } } while (0)
                        FIN_LOAD(ov0, rr0, kk0, vv0, gg0, wave * 8);
                        for (int i8 = wave * 8; i8 < 1024; i8 += 128) {
                            FIN_LOAD(ov1, rr1, kk1, vv1, gg1, i8 + 64);
                            FIN_COMP(ov0, rr0, kk0, vv0, gg0, i8);
                            if (i8 + 128 < 1024) FIN_LOAD(ov0, rr0, kk0, vv0, gg0, i8 + 128);
                            FIN_COMP(ov1, rr1, kk1, vv1, gg1, i8 + 64);
                        }
#undef FIN_LOAD
#undef FIN_COMP
                    }
                }
                if (tid == 0) { while (__hip_atomic_load(sbar, __ATOMIC_RELAXED, __HIP_MEMORY_SCOPE_AGENT) < nsub * (unsigned)(2 * l + 2)) __builtin_amdgcn_s_sleep(8);
                                __builtin_amdgcn_fence(__ATOMIC_ACQUIRE, "agent"); asm volatile("s_waitcnt vmcnt(0)" ::: "memory"); }
                __syncthreads();
            } else {
                if (nscan == 0) { for (int sb = bx; sb < 64; sb += G) rw_scan(lds, SCN, OSC, sb); }
                {   SchedA2 Sd{(const char*)xb, (const char*)((bf16_t*)(ws + WS_WIN) + (size_t)l * NP * DM), bx - nscan, G - nscan, nscan ? A2_MAIN : 43 * 32};
                    EpiA E{P, PRW, ssqx, ssq_cq, ssq_ckv, ssq_kr};
                    pg8::gemm_phase(lds, DM, DM, Sd, E); }
                grid_bar(sbar, nsub * (unsigned)(2 * l + 1));
                {   SchedB Sd{(const char*)P, (const char*)((bf16_t*)(ws + WS_WUQ) + (size_t)l * 2048 * 512), (const char*)((bf16_t*)(ws + WS_WUKV) + (size_t)l * 2048 * 512), G - nscan, vblock(bx - nscan, G - nscan)};
                    EpiB E{Qf, Kf, Vf, P, ssq_cq, ssq_ckv, ssq_kr, a.in[7] + l * 192, a.in[8] + l * 192, rope, (LAS float*)(lds + LDS_SCR)};
                    pg8::gemm_phase(lds, NP, 512, Sd, E); }
                grid_bar(sbar, nsub * (unsigned)(2 * l + 2));
            }
            unsigned* queue = (unsigned*)(ws + WS_CTL) + CTL_QUEUE + l * 64 + rep * 32;
            LAS unsigned* ubox = (LAS unsigned*)(lds + LDS_SCR + 8192);
            for (;;) {
#if defined(DUPC_SCANONLY)
                if (rep) break;
#endif
                if (tid == 0) *ubox = atomicAdd(queue, 1u);
                __syncthreads();
                const unsigned u = *ubox;
                __syncthreads();
                if (u >= 384u) break;
                if (u < 256u) {
                    const int qb = 15 - (int)(u >> 4), bh = u & 15, b = bh >> 3, h = bh & 7;
                    const size_t t0 = (size_t)b * S + qb * 256, tb = (size_t)b * S;
#ifndef NO_MLA
                    attn_unit<192, false>(lds, Qf + t0 * 1536 + h * 192, 1536, Kf + tb * 1536 + h * 192, 1536, Vf + tb * 1024 + h * 128, 1024,
                                          P + t0 * NP + PC_MG + h * 128, NP, ycat + t0 * DM + 512 + h * 128, DM, qb);
#endif
                } else {
                    const unsigned u2 = u - 256u; const int qb = 15 - (int)(u2 >> 3), bh = u2 & 7, b = bh >> 2, h = bh & 3;
                    const size_t t0 = (size_t)b * S + qb * 256, tb = (size_t)b * S;
#ifndef NO_SB
                    attn_unit<128, true>(lds, P + t0 * NP + PC_SBQ + h * 128, NP, P + tb * NP + PC_SBK + h * 128, NP, P + tb * NP + PC_SBV + h * 128, NP,
                                         P + t0 * NP + PC_SBG + h * 128, NP, ycat + t0 * DM + h * 128, DM, qb);
#endif
                }
            }
        } }
        SEAM();
        if (PH_ON()) {
            if (G != 256) { for (int it0 = gw * 4; it0 < T * 8; it0 += ngw * 4) rw_finaliseN<4>(it0, 1, a.in[17] + l * 512, a.in[18] + l * 512, a.in[16] + l * 512, OSC, SCN, P, ycat); }
        }
        if (G != 256) { SEAM(); } else { ++ph; }
        for (int rep = 0; rep < (((DUPMASK) & 32) ? 2 : 1); ++rep) { if (rep) GBAR(); if (PH_ON() && (PHMASK & 32)) {
            SchedD Sd{(const char*)ycat, (const char*)((bf16_t*)(ws + WS_WBR) + (size_t)l * DM * DM), G, vc};
            EpiD E{Mb, P};
            pg8::gemm_phase(lds, DM, DM, Sd, E);
        } }
        SEAM();
        for (int rep = 0; rep < (((DUPMASK) & 64) ? 2 : 1); ++rep) { if (rep) GBAR(); if (PH_ON() && (PHMASK & 64)) {
            SchedE Sd{(const char*)Mb, (const char*)((bf16_t*)(ws + WS_WOUT) + (size_t)l * DM * DM), G, vc};
            if (rep && l == 1) break;
            EpiE E{l == 0 ? x_in : a.out, a.out, xb, l == 0 ? (ctl + CTL_SSQX + T) : nullptr, rep != 0};
            pg8::gemm_phase(lds, DM, DM, Sd, E);
        } }
        SEAM();
    }
}

#ifndef MK_MULTI
#define MK_MULTI 0
#endif
extern "C" void kernel_launch(void* const* d_in, const int* in_sizes, int n_in, void* d_out, int out_size, void* d_ws, size_t ws_size, hipStream_t stream) {
    static int grid = 0;
    if (grid == 0) {
        if (n_in != 23 || out_size != T * DM || ws_size < WS_END) { fprintf(stderr, "kernel_launch: unexpected shapes (n_in %d out %d ws %zu)\n", n_in, out_size, ws_size); grid = -1; return; }
        int dev = 0, cus = 0, per_cu = 0;
        (void)hipGetDevice(&dev);
        (void)hipDeviceGetAttribute(&cus, hipDeviceAttributeMultiprocessorCount, dev);
        (void)hipFuncSetAttribute((const void*)fwd, hipFuncAttributeMaxDynamicSharedMemorySize, LDS_BYTES);
        (void)hipOccupancyMaxActiveBlocksPerMultiprocessor(&per_cu, (const void*)fwd, 512, LDS_BYTES);
        if (per_cu < 1) per_cu = 1;
        grid = cus * per_cu;
    }
    if (grid < 0) return;
    (void)hipMemsetAsync((char*)d_ws + WS_CTL, 0, 1 * MiB, stream);
    Args a{};
    for (int i = 0; i < 23; ++i) a.in[i] = (const float*)d_in[i];
    a.out = (float*)d_out; a.ws = (unsigned char*)d_ws;
#if MK_MULTI
    for (int p = 0; p < 13; ++p) { a.ph_lo = p; a.ph_hi = p + 1; hipLaunchKernelGGL(fwd, dim3(grid), dim3(512), LDS_BYTES, stream, a); }
#else
    a.ph_lo = 0; a.ph_hi = 13;
    void* args[] = {&a};
    hipError_t e = hipLaunchCooperativeKernel((const void*)fwd, dim3(grid), dim3(512), args, LDS_BYTES, stream);
    if (e != hipSuccess) fprintf(stderr, "cooperative launch failed: %s (grid %d)\n", hipGetErrorString(e), grid);
#endif
}
```

```cpp
#include <hip/hip_runtime.h>
#include <hip/hip_cooperative_groups.h>
#include <cstdio>
#include <cstdint>
namespace cg = cooperative_groups;

#define LAS __attribute__((address_space(3)))
typedef unsigned short bf16_t;
typedef short bf16x8 __attribute__((ext_vector_type(8)));
typedef short s16x4 __attribute__((ext_vector_type(4)));
typedef float f32x2 __attribute__((ext_vector_type(2)));
typedef float f32x4 __attribute__((ext_vector_type(4)));
typedef float f32x16 __attribute__((ext_vector_type(16)));
typedef unsigned u32x4 __attribute__((ext_vector_type(4)));
typedef unsigned u32x2 __attribute__((ext_vector_type(2)));

constexpr int T = 8192, S = 4096, DM = 2048, NP = 12800;
constexpr int PRW_LD = 1792;
constexpr int PC_SBQ = 0, PC_SBK = 512, PC_SBV = 1024, PC_SBG = 1536, PC_CQ = 2048, PC_CKV = 2560, PC_KR = 3072, PC_MG = 3328,
              PC_RG = 6144, PC_GATE = 6656;
constexpr float EPS = 1e-6f;
constexpr float CQ_MLA = 0.10411754627697264f;
constexpr float SCALE_SB = 0.08838834764831845f;

constexpr size_t MiB = 1u << 20;
constexpr size_t WS_CTL = 0, WS_ROPE = 1 * MiB, WS_WIN = 2 * MiB, WS_WUQ = 102 * MiB, WS_WUKV = 106 * MiB, WS_WBR = 110 * MiB, WS_WOUT = 126 * MiB,
                 WS_XB = 142 * MiB, WS_P = 174 * MiB, WS_PRW = 374 * MiB, WS_QF = 430 * MiB, WS_KF = 454 * MiB, WS_VF = 478 * MiB, WS_SCN = 494 * MiB,
                 WS_OSC = 590 * MiB, WS_YCAT = 606 * MiB, WS_MRG32 = 638 * MiB, WS_MRGB = 702 * MiB, WS_END = 734 * MiB;
constexpr int CTL_SSQX = 0, CTL_SSQCQ = 2 * T, CTL_SSQCKV = 4 * T, CTL_SSQKR = 6 * T, CTL_QUEUE = 131072;

constexpr int LDS_RING = 131072, LDS_SCR = 131072, LDS_BYTES = 147456;

__device__ __forceinline__ unsigned f2bf(float f) { unsigned u = __builtin_bit_cast(unsigned, f); return (u + 0x7fffu + ((u >> 16) & 1u)) >> 16; }
__device__ __forceinline__ unsigned pk2(float lo, float hi) { return f2bf(lo) | (f2bf(hi) << 16); }
__device__ __forceinline__ unsigned cvtpk(float lo, float hi) { unsigned r; asm volatile("v_cvt_pk_bf16_f32 %0, %1, %2" : "=v"(r) : "v"(lo), "v"(hi)); return r; }
__device__ __forceinline__ float bf2f(unsigned short b) { return __builtin_bit_cast(float, (unsigned)b << 16); }
__device__ __forceinline__ float bflo(unsigned w) { return __builtin_bit_cast(float, w << 16); }
__device__ __forceinline__ float bfhi(unsigned w) { return __builtin_bit_cast(float, w & 0xffff0000u); }
__device__ __forceinline__ float wave_sum(float v) {
#pragma unroll
    for (int o = 1; o < 64; o <<= 1) v += __shfl_xor(v, o);
    return v;
}
__device__ __forceinline__ float fsigmoid(float x) { return __builtin_amdgcn_rcpf(1.f + __expf(-x)); }
__device__ __forceinline__ float fsilu(float x) { return x * fsigmoid(x); }
#define LDS_WAIT() asm volatile("s_waitcnt lgkmcnt(0)" ::: "memory")

namespace pg8 {
constexpr int BM = 256, BK = 64, HALF = 128, HTB = HALF * BK * 2;
__device__ __forceinline__ int lds_byte(int r, int c) { const int st = (r >> 4) * 2 + (c >> 5), rr = r & 15, cc = c & 31, ob = rr * 64 + cc * 2; return st * 1024 + (ob ^ (((ob >> 9) & 1) << 5)); }
__device__ __forceinline__ void stage_rc(int b, int& R, int& C) { const int st = b / 1024, sb = b % 1024, swz = sb ^ (((sb >> 9) & 1) << 5); R = (st >> 1) * 16 + swz / 64; C = (st & 1) * 32 + (swz % 64) / 2; }
__device__ __forceinline__ int perm32(int rho) { const int n = rho >> 4, i = rho & 15; return 8 * (i >> 2) + 4 * n + (i & 3); }

struct GUnit { const char* A; const char* B; int nt, pm, pn, aux; };

template <class Epi, class Sched>
__device__ __forceinline__ void gemm_phase(LAS unsigned char* lds, const int lda, const int ldb, const Sched& S, const Epi& E) {
    int tid = threadIdx.x; asm volatile("" : "+v"(tid));
    const int wid = __builtin_amdgcn_readfirstlane(tid >> 6), lane = tid & 63, wr = wid >> 2, wc = wid & 3, fr = lane & 15, fq = lane >> 4;
    unsigned voffA[2], voffB[2];
#pragma unroll
    for (int i = 0; i < 2; ++i) { int R, C; stage_rc(tid * 16 + i * 8192, R, C); const int Rb = (R & ~31) + perm32(R & 31);
        voffA[i] = (unsigned)(R * lda + C) * 2u; voffB[i] = (unsigned)(Rb * ldb + C) * 2u; }
    const size_t kstep = (size_t)(BK * 2);
    const size_t hstepA = (size_t)HALF * lda * 2, hstepB = (size_t)HALF * ldb * 2;
    const unsigned ldsw = (unsigned)wid * 1024u;
    const int aoff = lds_byte(wr * 64 + fr, fq * 8), boff = lds_byte(wc * 32 + fr, fq * 8);
#define PG8_SA(b, h) (((b) * 2 + (h)) * HTB)
#define PG8_SB(b, h) ((4 + (b) * 2 + (h)) * HTB)
#define PG8_STAGE(bufoff, gbase, voff) do { _Pragma("unroll") for (int _i = 0; _i < 2; ++_i) \
        __builtin_amdgcn_global_load_lds((const unsigned*)((const char*)(gbase) + (voff)[_i]), (LAS unsigned*)(lds + (bufoff) + ldsw + _i * 8192), 16, 0, 0); } while (0)
#define PG8_LDA(dst, b, h) do { _Pragma("unroll") for (int m = 0; m < 4; ++m) _Pragma("unroll") for (int k = 0; k < 2; ++k) dst[m][k] = *(const LAS bf16x8*)(lds + PG8_SA(b, h) + aoff + m * 2048 + k * 1024); } while (0)
#define PG8_LDB(dst, b, h) do { _Pragma("unroll") for (int n = 0; n < 2; ++n) _Pragma("unroll") for (int k = 0; k < 2; ++k) dst[n][k] = *(const LAS bf16x8*)(lds + PG8_SB(b, h) + boff + n * 2048 + k * 1024); } while (0)
#define PG8_MMA(ai, bj, At, Bt) do { __builtin_amdgcn_s_setprio(1); _Pragma("unroll") for (int m = 0; m < 4; ++m) _Pragma("unroll") for (int n = 0; n < 2; ++n) _Pragma("unroll") for (int k = 0; k < 2; ++k) \
        acc[ai][bj][m][n] = __builtin_amdgcn_mfma_f32_16x16x32_bf16(Bt[n][k], At[m][k], acc[ai][bj][m][n], 0, 0, 0); __builtin_amdgcn_s_setprio(0); } while (0)
#define PG8_WAIT_V(n) asm volatile("s_waitcnt vmcnt(" #n ")" ::: "memory")
#define PG8_WAIT_L(n) asm volatile("s_waitcnt lgkmcnt(" #n ")" ::: "memory")
#define PG8_BAR __builtin_amdgcn_s_barrier()
#define PG8_SCHED __builtin_amdgcn_sched_barrier(0)
    GUnit cur, nxt; int ui = 0;
    if (!S.next(0, cur)) return;
    f32x4 acc[2][2][4][2];
#pragma unroll
    for (int a = 0; a < 2; ++a)
#pragma unroll
        for (int b = 0; b < 2; ++b)
#pragma unroll
            for (int m = 0; m < 4; ++m)
#pragma unroll
                for (int n = 0; n < 2; ++n) acc[a][b][m][n] = (f32x4){0.f, 0.f, 0.f, 0.f};
    bf16x8 At[4][2], B0[2][2], B1[2][2];
    const char* cA = cur.A; const char* cB = cur.B;
    PG8_STAGE(PG8_SB(0, 0), cB, voffB); PG8_STAGE(PG8_SB(0, 1), cB + hstepB, voffB); PG8_STAGE(PG8_SA(0, 0), cA, voffA); PG8_STAGE(PG8_SA(0, 1), cA + hstepA, voffA);
    if (wr == 1) PG8_BAR;
    PG8_WAIT_V(2); PG8_BAR;
    PG8_STAGE(PG8_SB(1, 0), cB + kstep, voffB); PG8_STAGE(PG8_SA(1, 0), cA + kstep, voffA); PG8_STAGE(PG8_SB(1, 1), cB + hstepB + kstep, voffB);
    PG8_WAIT_V(6); PG8_BAR;
    for (;;) {
        const bool has_next = S.next(ui + 1, nxt);
        const char* nA = has_next ? nxt.A : cA; const char* nB = has_next ? nxt.B : cB;
        const int nt = cur.nt;
        for (int t = 0; t < nt; t += 2) {
            if constexpr (Epi::HAS_MID) { if (t == 8 || t == 24) { int fr_ = fr, fq_ = fq; asm volatile("" : "+v"(fr_), "+v"(fq_)); E.mid(acc, cur, t, wr, wc, fr_, fq_); } }
            const bool last = (t == nt - 2);
            const char* a1 = cA + (size_t)(t + 1) * kstep;
            const char* a2 = last ? nA : cA + (size_t)(t + 2) * kstep; const char* b2 = last ? nB : cB + (size_t)(t + 2) * kstep;
            const char* a3 = a2 + kstep; const char* b3 = b2 + kstep;
            PG8_LDB(B0, 0, 0); PG8_LDB(B1, 0, 1); PG8_SCHED; PG8_LDA(At, 0, 0); PG8_STAGE(PG8_SA(1, 1), a1 + hstepA, voffA);
            PG8_WAIT_V(8); PG8_WAIT_L(0); PG8_BAR; PG8_MMA(0, 0, At, B0); PG8_MMA(0, 1, At, B1); PG8_BAR; PG8_SCHED;
            PG8_LDA(At, 0, 1); PG8_STAGE(PG8_SB(0, 0), b2, voffB); PG8_STAGE(PG8_SB(0, 1), b2 + hstepB, voffB); PG8_STAGE(PG8_SA(0, 0), a2, voffA);
            PG8_WAIT_V(8); PG8_WAIT_L(0); PG8_BAR; PG8_MMA(1, 0, At, B0); PG8_MMA(1, 1, At, B1); PG8_BAR; PG8_SCHED;
            PG8_LDB(B0, 1, 0); PG8_LDB(B1, 1, 1); PG8_SCHED; PG8_LDA(At, 1, 0); PG8_STAGE(PG8_SA(0, 1), a2 + hstepA, voffA);
            PG8_WAIT_V(8); PG8_WAIT_L(0); PG8_BAR; PG8_MMA(0, 0, At, B0); PG8_MMA(0, 1, At, B1); PG8_BAR; PG8_SCHED;
            PG8_LDA(At, 1, 1); PG8_STAGE(PG8_SB(1, 0), b3, voffB); PG8_STAGE(PG8_SB(1, 1), b3 + hstepB, voffB); PG8_STAGE(PG8_SA(1, 0), a3, voffA);
            PG8_WAIT_V(8); PG8_WAIT_L(0); PG8_BAR; PG8_MMA(1, 0, At, B0); PG8_MMA(1, 1, At, B1); PG8_BAR; PG8_SCHED;
        }
        if (wr == 0) PG8_BAR;
        { GUnit eu = cur; eu.pm = __builtin_amdgcn_readfirstlane(cur.pm); eu.pn = __builtin_amdgcn_readfirstlane(cur.pn); eu.aux = __builtin_amdgcn_readfirstlane(cur.aux);
          int wr_ = wr, wc_ = wc, fr_ = fr, fq_ = fq;
          asm volatile("" : "+s"(eu.pm), "+s"(eu.pn), "+s"(eu.aux), "+s"(wr_), "+s"(wc_), "+v"(fr_), "+v"(fq_));
          E(acc, eu, wr_, wc_, fr_, fq_); }
        if (!has_next) break;
#pragma unroll
        for (int a = 0; a < 2; ++a)
#pragma unroll
            for (int b = 0; b < 2; ++b)
#pragma unroll
                for (int m = 0; m < 4; ++m)
#pragma unroll
                    for (int n = 0; n < 2; ++n) acc[a][b][m][n] = (f32x4){0.f, 0.f, 0.f, 0.f};
        cur = nxt; cA = nA; cB = nB; ++ui;
        if (wr == 1) PG8_BAR;
    }
    PG8_WAIT_V(0);
    PG8_BAR;
#undef PG8_SA
#undef PG8_SB
#undef PG8_STAGE
#undef PG8_LDA
#undef PG8_LDB
#undef PG8_MMA
#undef PG8_WAIT_V
#undef PG8_WAIT_L
#undef PG8_SCHED
}
}
using pg8::GUnit;

#define XB_TMO      128
#define XB_XCNT(j)  (256  + 64 * (j))
#define XB_XSUB(j)  (1280 + 64 * (j))
#define XB_XGEN(j)  (2304 + 64 * (j))
#define XB_TOP      3328
#define XB_TOPGEN   3392
#define XCD_BAR_WORDS 3456
#define XB_SPIN_CAP (1u << 18)

__device__ __forceinline__ unsigned xb_ld(unsigned* p)              { return __hip_atomic_load(p, __ATOMIC_RELAXED, __HIP_MEMORY_SCOPE_AGENT); }
__device__ __forceinline__ unsigned xb_add(unsigned* p, unsigned v) { return __hip_atomic_fetch_add(p, v, __ATOMIC_RELAXED, __HIP_MEMORY_SCOPE_AGENT); }
__device__ __forceinline__ unsigned xb_xcc_id() { return (unsigned)__builtin_amdgcn_s_getreg((3 << 11) | 20) & 0xFu; }
#define XB_SPIN(cond, bar) do { unsigned _sp = 0; while (cond) { __builtin_amdgcn_s_sleep(1); \
    if ((++_sp & 255u) == 0u) { if (xb_ld(&(bar)[XB_TMO])) break; if (_sp > XB_SPIN_CAP) { atomicAdd(&(bar)[XB_TMO], 1u); break; } } } } while (0)

struct XcdBarrier {
    unsigned* bar; unsigned x;
    volatile LAS unsigned* st;
};

__device__ __forceinline__ XcdBarrier xcd_barrier_post(unsigned* bar, volatile LAS unsigned* st) {
    XcdBarrier b; b.bar = bar; b.x = xb_xcc_id(); b.st = st;
    if (threadIdx.x == 0) (void)xb_add(&bar[XB_XCNT(b.x)], 1u);
    return b;
}
__device__ __forceinline__ void xcd_barrier_complete(unsigned* bar, unsigned x, unsigned& nloc, unsigned& nx) {
    const unsigned G = gridDim.x * gridDim.y * gridDim.z;
    unsigned sum, cnt, mine, sp = 0u;
    for (;;) {
        sum = 0u; cnt = 0u; mine = 0u;
#pragma unroll
        for (unsigned j = 0; j < 16; ++j) { const unsigned c = xb_ld(&bar[XB_XCNT(j)]); sum += c; cnt += (c > 0u) ? 1u : 0u; mine = (j == x) ? c : mine; }
        if (sum == G) break;
        __builtin_amdgcn_s_sleep(1);
        if ((++sp & 255u) == 0u) { if (xb_ld(&bar[XB_TMO])) break; if (sp > XB_SPIN_CAP) { atomicAdd(&bar[XB_TMO], 1u); break; } }
    }
    nloc = mine > 0u ? mine : 1u; nx = cnt > 0u ? cnt : 1u;
}

__device__ __forceinline__ void xcd_barrier(const XcdBarrier& b) {
    asm volatile("s_waitcnt vmcnt(0)" ::: "memory");
    __syncthreads();
    if (threadIdx.x == 0) {
        unsigned* bar = b.bar;
        __builtin_amdgcn_s_waitcnt(0);
        unsigned nloc = b.st[0], nx = b.st[1];
        if (nloc == 0u) { xcd_barrier_complete(bar, b.x, nloc, nx); b.st[0] = nloc; b.st[1] = nx; }
        const unsigned old = xb_add(&bar[XB_XSUB(b.x)], 1u);
        const unsigned gen = old / nloc;
        if (old + 1u == (gen + 1u) * nloc) {
            __builtin_amdgcn_fence(__ATOMIC_RELEASE, "agent");
            asm volatile("s_waitcnt vmcnt(0)" ::: "memory");
            const unsigned og = xb_add(&bar[XB_TOP], 1u);
            const unsigned tg = og / nx;
            if (og + 1u == (tg + 1u) * nx) xb_add(&bar[XB_TOPGEN], 1u);
            else XB_SPIN(xb_ld(&bar[XB_TOPGEN]) == tg, bar);
            __builtin_amdgcn_fence(__ATOMIC_ACQUIRE, "agent");
            xb_add(&bar[XB_XGEN(b.x)], 1u);
            asm volatile("s_waitcnt vmcnt(0)" ::: "memory");
        } else {
            XB_SPIN(xb_ld(&bar[XB_XGEN(b.x)]) == gen, bar);
            __builtin_amdgcn_fence(__ATOMIC_ACQUIRE, "agent");
            asm volatile("s_waitcnt vmcnt(0)" ::: "memory");
        }
    }
    __syncthreads();
}


__device__ __forceinline__ void grid_bar(unsigned* cnt, unsigned target) {
    asm volatile("s_waitcnt vmcnt(0) lgkmcnt(0)" ::: "memory");
    __syncthreads();
    if (threadIdx.x == 0) {
        __builtin_amdgcn_fence(__ATOMIC_RELEASE, "agent");
        asm volatile("s_waitcnt vmcnt(0)" ::: "memory");
        __hip_atomic_fetch_add(cnt, 1u, __ATOMIC_RELAXED, __HIP_MEMORY_SCOPE_AGENT);
        while (__hip_atomic_load(cnt, __ATOMIC_RELAXED, __HIP_MEMORY_SCOPE_AGENT) < target) __builtin_amdgcn_s_sleep(1);
        __builtin_amdgcn_fence(__ATOMIC_ACQUIRE, "agent");
        asm volatile("s_waitcnt vmcnt(0)" ::: "memory");
    }
    __syncthreads();
}

__device__ __forceinline__ int vblock(int c, int G) { return (G % 8 == 0) ? (c % 8) * (G / 8) + c / 8 : c; }

struct SchedA {
    const char* A; const char* B; int G, c;
    __device__ __forceinline__ bool next(int i, GUnit& u) const {
        constexpr int nM = 32, nN = 50, nwg = nM * nN, NXCD = 8, WGM = 8;
        const long L = (long)i * G + c; if (L >= nwg) return false;
        int wgid = (int)L; { const int q = nwg / NXCD, r = nwg % NXCD, xcd = wgid % NXCD, off = wgid / NXCD; wgid = (xcd < r ? xcd * (q + 1) : r * (q + 1) + (xcd - r) * q) + off; }
        const int nig = WGM * nN, gid = wgid / nig, fm = gid * WGM, gsz = (nM - fm) < WGM ? (nM - fm) : WGM;
        u.pm = fm + ((wgid % nig) % gsz); u.pn = (wgid % nig) / gsz; u.nt = 32; u.aux = 0;
        u.A = A + (size_t)u.pm * 256 * DM * 2; u.B = B + (size_t)u.pn * 256 * DM * 2; return true;
    }
};
struct SchedA2 {
    const char* A; const char* B; int first, stride, limit;
    __device__ __forceinline__ bool next(int i, GUnit& u) const {
        constexpr int nM = 32, nN = 43, nwg = nM * nN, NXCD = 8, WGM = 8;
        const int L = first + i * stride; if (L >= limit) return false;
        int wgid = L; { const int q = nwg / NXCD, r = nwg % NXCD, xcd = wgid % NXCD, off = wgid / NXCD; wgid = (xcd < r ? xcd * (q + 1) : r * (q + 1) + (xcd - r) * q) + off; }
        const int nig = WGM * nN, gid = wgid / nig, fm = gid * WGM, gsz = (nM - fm) < WGM ? (nM - fm) : WGM;
        u.pm = fm + ((wgid % nig) % gsz); const int pn = (wgid % nig) / gsz; u.pn = pn < 17 ? pn : pn + 7; u.nt = 32; u.aux = 0;
        u.A = A + (size_t)u.pm * 256 * DM * 2; u.B = B + (size_t)u.pn * 256 * DM * 2; return true;
    }
};
struct SchedA1 {
    const char* A; const char* B; int G, vc, extra;
    __device__ __forceinline__ bool next(int i, GUnit& u) const {
        const int L = i * G + vc; if (L >= 224 + extra) return false;
        if (L >= 224) { SchedA2 s2{A, B, 43 * 32 - 32 + (L - 224), 1 << 20, 43 * 32}; return s2.next(0, u); }
        u.pm = L / 7; u.pn = 17 + L % 7; u.nt = 32; u.aux = 0;
        u.A = A + (size_t)u.pm * 256 * DM * 2; u.B = B + (size_t)u.pn * 256 * DM * 2; return true;
    }
};
struct SchedB {
    const char* P; const char* Wq; const char* Wkv; int G, vc;
    __device__ __forceinline__ bool next(int i, GUnit& u) const {
        const int L = i * G + vc; if (L >= 512) return false;
        const int isq = (L < 256), l2 = L & 255; u.pm = l2 >> 3; u.pn = l2 & 7; u.nt = 8; u.aux = isq ? 0 : 1;
        u.A = P + ((size_t)u.pm * 256 * NP + (isq ? PC_CQ : PC_CKV)) * 2; u.B = (isq ? Wq : Wkv) + (size_t)u.pn * 256 * 512 * 2; return true;
    }
};
struct SchedD {
    const char* Y; const char* W; int G, vc;
    __device__ __forceinline__ bool next(int i, GUnit& u) const {
        const int tile = i * G + vc; if (tile >= 256) return false;
        u.pm = tile >> 3; u.pn = tile & 7; u.aux = 0; u.nt = 32;
        u.A = Y + (size_t)u.pm * 256 * DM * 2; u.B = W + (size_t)u.pn * 256 * DM * 2; return true;
    }
};
struct SchedE {
    const char* A; const char* B; int G, vc;
    __device__ __forceinline__ bool next(int i, GUnit& u) const {
        const int tile = i * G + vc; if (tile >= 256) return false;
        u.pm = tile >> 3; u.pn = tile & 7; u.aux = 0; u.nt = 32;
        u.A = A + (size_t)u.pm * 256 * DM * 2; u.B = B + (size_t)u.pn * 256 * DM * 2; return true;
    }
};

struct EpiA {
    static constexpr bool HAS_MID = false;
    bf16_t* P; float* PRW; const float* ssqx; float* ssq_cq; float* ssq_ckv; float* ssq_kr;
    __device__ __forceinline__ void operator()(const f32x4 (&acc)[2][2][4][2], const GUnit& u, int wr, int wc, int fr, int fq) const {
        const int pn = u.pn;
        const int kind = (pn < 6) ? 0 : (pn < 8) ? 1 : (pn < 13) ? 0 : (pn < 17) ? 1 : (pn < 24) ? 3 : (pn < 26) ? 1 : 2;
        float* ssq = (pn >= 8 && pn < 10) ? ssq_cq : (pn >= 10 && pn < 12) ? ssq_ckv : (pn == 12) ? ssq_kr : nullptr;
        const int row0 = u.pm * 256 + wr * 64 + fr;
        float rsv[2][4];
#pragma unroll
        for (int ai = 0; ai < 2; ++ai)
#pragma unroll
            for (int m = 0; m < 4; ++m) rsv[ai][m] = ssqx[row0 + ai * 128 + m * 16];
#pragma unroll
        for (int ai = 0; ai < 2; ++ai)
#pragma unroll
            for (int m = 0; m < 4; ++m) rsv[ai][m] = rsqrtf(rsv[ai][m] * (1.f / 2048.f) + EPS);
#pragma unroll
        for (int ai = 0; ai < 2; ++ai)
#pragma unroll
            for (int m = 0; m < 4; ++m) {
                const int row = row0 + ai * 128 + m * 16;
                const float rs = rsv[ai][m];
                float sq = 0.f;
#pragma unroll
                for (int bj = 0; bj < 2; ++bj) {
                    f32x4 v0 = acc[ai][bj][m][0] * rs, v1 = acc[ai][bj][m][1] * rs;
                    const int cl = bj * 128 + wc * 32 + 8 * fq;
                    if (kind == 3) {
                        float* o = PRW + (size_t)row * PRW_LD + (pn - 17) * 256 + cl;
                        *(f32x4*)o = v0; *(f32x4*)(o + 4) = v1;
                    } else {
                        if (ssq) sq += (v0[0] * v0[0] + v0[1] * v0[1]) + (v0[2] * v0[2] + v0[3] * v0[3]) + (v1[0] * v1[0] + v1[1] * v1[1]) + (v1[2] * v1[2] + v1[3] * v1[3]);
                        if (kind == 1) {
#pragma unroll
                            for (int e = 0; e < 4; ++e) { v0[e] = fsilu(v0[e]); v1[e] = fsilu(v1[e]); }
                        } else if (kind == 2) {
#pragma unroll
                            for (int e = 0; e < 4; ++e) { v0[e] = fsigmoid(v0[e]); v1[e] = fsigmoid(v1[e]); }
                        }
                        u32x4 w; w.x = cvtpk(v0[0], v0[1]); w.y = cvtpk(v0[2], v0[3]); w.z = cvtpk(v1[0], v1[1]); w.w = cvtpk(v1[2], v1[3]);
                        *(u32x4*)(P + (size_t)row * NP + pn * 256 + cl) = w;
                    }
                }
                if (ssq) { sq += __shfl_xor(sq, 16); sq += __shfl_xor(sq, 32); if (fq == 0) atomicAdd(ssq + row, sq); }
            }
    }
};

struct EpiB {
    static constexpr bool HAS_MID = false;
    bf16_t* Qf; bf16_t* Kf; bf16_t* Vf; const bf16_t* P; const float* ssq_cq; const float* ssq_ckv; const float* ssq_kr;
    const float* qn_g; const float* kn_g; const float* rope; LAS float* scr;
    __device__ __forceinline__ void operator()(const f32x4 (&acc)[2][2][4][2], const GUnit& u, int wr, int wc, int fr, int fq) const {
        const int h = u.pn; const bool isq = (u.aux == 0);
        const float* ssqA = isq ? ssq_cq : ssq_ckv;
        LAS float* part = scr; LAS float* rstdL = scr + 1024;
        const int row0 = u.pm * 256 + wr * 64 + fr;
        float sv[2][4], krv[2][4];
#pragma unroll
        for (int ai = 0; ai < 2; ++ai)
#pragma unroll
            for (int m = 0; m < 4; ++m) { const int row = row0 + ai * 128 + m * 16; sv[ai][m] = ssqA[row]; krv[ai][m] = isq ? 0.f : ssq_kr[row]; }
#pragma unroll
        for (int ai = 0; ai < 2; ++ai)
#pragma unroll
            for (int m = 0; m < 4; ++m) sv[ai][m] = rsqrtf(sv[ai][m] * (1.f / 512.f) + EPS);
#pragma unroll
        for (int ai = 0; ai < 2; ++ai)
#pragma unroll
            for (int m = 0; m < 4; ++m) {
                const float s = sv[ai][m];
                float sq = 0.f;
#pragma unroll
                for (int bj = 0; bj < 2; ++bj) {
                    if (!isq && bj == 1) continue;
                    const f32x4 v0 = acc[ai][bj][m][0] * s, v1 = acc[ai][bj][m][1] * s;
                    sq += (v0[0] * v0[0] + v0[1] * v0[1]) + (v0[2] * v0[2] + v0[3] * v0[3]) + (v1[0] * v1[0] + v1[1] * v1[1]) + (v1[2] * v1[2] + v1[3] * v1[3]);
                }
                sq += __shfl_xor(sq, 16); sq += __shfl_xor(sq, 32);
                if (fq == 0) part[(ai * 128 + wr * 64 + m * 16 + fr) * 4 + wc] = sq;
                __builtin_amdgcn_sched_barrier(0);
            }
        LDS_WAIT(); PG8_BAR;
        const float* gq = isq ? qn_g : kn_g;
        const int c0 = wc * 32 + 8 * fq;
        f32x4 g0 = *(const f32x4*)(gq + c0), g1 = *(const f32x4*)(gq + c0 + 4);
        const int j = 4 * wc + fq;
        f32x4 gr1 = (f32x4){0.f, 0.f, 0.f, 0.f}, gr2 = gr1;
        if (isq && wc < 2) { gr1 = *(const f32x4*)(qn_g + 128 + 4 * j); gr2 = *(const f32x4*)(qn_g + 160 + 4 * j); }
#pragma unroll
        for (int ai = 0; ai < 2; ++ai)
#pragma unroll
            for (int m = 0; m < 4; ++m) {
                const int rl = ai * 128 + wr * 64 + m * 16 + fr, row = u.pm * 256 + rl;
                const f32x4 pp = *(const LAS f32x4*)(part + rl * 4);
                float tot = (pp[0] + pp[1]) + (pp[2] + pp[3]);
                if (!isq) tot += krv[ai][m];
                const float rstd = rsqrtf(tot * (1.f / 192.f) + EPS);
                const float s = sv[ai][m];
                if (isq) {
                    const float f = s * rstd * CQ_MLA;
                    { const f32x4 v0 = acc[ai][0][m][0] * f * g0, v1 = acc[ai][0][m][1] * f * g1;
                      u32x4 w; w.x = cvtpk(v0[0], v0[1]); w.y = cvtpk(v0[2], v0[3]); w.z = cvtpk(v1[0], v1[1]); w.w = cvtpk(v1[2], v1[3]);
                      *(u32x4*)(Qf + (size_t)row * 1536 + h * 192 + c0) = w; }
                    if (wc < 2) {
                        const int pos = row & (S - 1);
                        const f32x4 cs = *(const f32x4*)(rope + pos * 32 + 4 * j), sn = *(const f32x4*)(rope + S * 32 + pos * 32 + 4 * j);
                        const f32x4 x1 = acc[ai][1][m][0] * f * gr1, x2 = acc[ai][1][m][1] * f * gr2;
                        const f32x4 y1 = x1 * cs - x2 * sn, y2 = x1 * sn + x2 * cs;
                        u32x4 w; w.x = cvtpk(y1[0], y1[1]); w.y = cvtpk(y1[2], y1[3]); w.z = cvtpk(y2[0], y2[1]); w.w = cvtpk(y2[2], y2[3]);
                        *(u32x4*)(Qf + (size_t)row * 1536 + h * 192 + 128 + 8 * j) = w;
                    }
                } else {
                    if (wc == 0 && fq == 0) rstdL[rl] = rstd;
                    const float f = s * rstd;
                    { const f32x4 v0 = acc[ai][0][m][0] * f * g0, v1 = acc[ai][0][m][1] * f * g1;
                      u32x4 w; w.x = cvtpk(v0[0], v0[1]); w.y = cvtpk(v0[2], v0[3]); w.z = cvtpk(v1[0], v1[1]); w.w = cvtpk(v1[2], v1[3]);
                      *(u32x4*)(Kf + (size_t)row * 1536 + h * 192 + c0) = w; }
                    { const f32x4 v0 = acc[ai][1][m][0] * s, v1 = acc[ai][1][m][1] * s;
                      u32x4 w; w.x = cvtpk(v0[0], v0[1]); w.y = cvtpk(v0[2], v0[3]); w.z = cvtpk(v1[0], v1[1]); w.w = cvtpk(v1[2], v1[3]);
                      *(u32x4*)(Vf + (size_t)row * 1024 + h * 128 + c0) = w; }
                }
                __builtin_amdgcn_sched_barrier(0);
            }
        if (!isq) {
            LDS_WAIT(); PG8_BAR;
            int tid = fr + 16 * fq + 64 * (wr * 4 + wc);
            const int rl = tid >> 1, jj0 = (tid & 1) * 4, row = u.pm * 256 + rl, pos = row & (S - 1);
            const float rstd = rstdL[rl];
            const bf16_t* kr = P + (size_t)row * NP + PC_KR;
#pragma unroll
            for (int jj = 0; jj < 4; ++jj) {
                const int j2 = jj0 + jj;
                const u32x2 a = *(const u32x2*)(kr + 4 * j2), b = *(const u32x2*)(kr + 32 + 4 * j2);
                const f32x4 ga = *(const f32x4*)(kn_g + 128 + 4 * j2), gb = *(const f32x4*)(kn_g + 160 + 4 * j2);
                const f32x4 cs = *(const f32x4*)(rope + pos * 32 + 4 * j2), sn = *(const f32x4*)(rope + S * 32 + pos * 32 + 4 * j2);
                const f32x4 x1 = (f32x4){bflo(a.x), bfhi(a.x), bflo(a.y), bfhi(a.y)} * rstd * ga, x2 = (f32x4){bflo(b.x), bfhi(b.x), bflo(b.y), bfhi(b.y)} * rstd * gb;
                const f32x4 y1 = x1 * cs - x2 * sn, y2 = x1 * sn + x2 * cs;
                u32x4 w; w.x = cvtpk(y1[0], y1[1]); w.y = cvtpk(y1[2], y1[3]); w.z = cvtpk(y2[0], y2[1]); w.w = cvtpk(y2[2], y2[3]);
                *(u32x4*)(Kf + (size_t)row * 1536 + h * 192 + 128 + 8 * j2) = w;
            }
        }
    }
};

struct EpiD {
    static constexpr bool HAS_MID = true;
    static constexpr float GMIN = 1e-5f;
    bf16_t* Mb; const bf16_t* P;
    __device__ __forceinline__ void mid(f32x4 (&acc)[2][2][4][2], const GUnit& u, int t, int wr, int wc, int fr, int fq) const {
        const int from = (t == 8) ? 0 : 1; const int row0 = u.pm * 256 + wr * 64 + fr;
        const int col0 = u.pn * 256 + wc * 32 + 8 * fq;
#pragma unroll
        for (int ai = 0; ai < 2; ++ai) {
            u32x4 ga[4][2], gb[4][2];
#pragma unroll
            for (int m = 0; m < 4; ++m)
#pragma unroll
                for (int bj = 0; bj < 2; ++bj) {
                    const bf16_t* gp = P + (size_t)(row0 + ai * 128 + m * 16) * NP + PC_GATE + from * 2048 + col0 + bj * 128;
                    ga[m][bj] = *(const u32x4*)gp; gb[m][bj] = *(const u32x4*)(gp + 2048);
                }
#pragma unroll
            for (int m = 0; m < 4; ++m)
#pragma unroll
                for (int bj = 0; bj < 2; ++bj) {
                    const u32x4 a_ = ga[m][bj], b_ = gb[m][bj];
                    f32x4 r0, r1;
                    r0[0] = fmaxf(bflo(a_.x), GMIN) * __builtin_amdgcn_rcpf(fmaxf(bflo(b_.x), GMIN)); r0[1] = fmaxf(bfhi(a_.x), GMIN) * __builtin_amdgcn_rcpf(fmaxf(bfhi(b_.x), GMIN));
                    r0[2] = fmaxf(bflo(a_.y), GMIN) * __builtin_amdgcn_rcpf(fmaxf(bflo(b_.y), GMIN)); r0[3] = fmaxf(bfhi(a_.y), GMIN) * __builtin_amdgcn_rcpf(fmaxf(bfhi(b_.y), GMIN));
                    r1[0] = fmaxf(bflo(a_.z), GMIN) * __builtin_amdgcn_rcpf(fmaxf(bflo(b_.z), GMIN)); r1[1] = fmaxf(bfhi(a_.z), GMIN) * __builtin_amdgcn_rcpf(fmaxf(bfhi(b_.z), GMIN));
                    r1[2] = fmaxf(bflo(a_.w), GMIN) * __builtin_amdgcn_rcpf(fmaxf(bflo(b_.w), GMIN)); r1[3] = fmaxf(bfhi(a_.w), GMIN) * __builtin_amdgcn_rcpf(fmaxf(bfhi(b_.w), GMIN));
                    acc[ai][bj][m][0] *= r0; acc[ai][bj][m][1] *= r1;
                }
            __builtin_amdgcn_sched_barrier(0);
        }
    }
    __device__ __forceinline__ void operator()(const f32x4 (&acc)[2][2][4][2], const GUnit& u, int wr, int wc, int fr, int fq) const {
        const int row0 = u.pm * 256 + wr * 64 + fr;
#pragma unroll
        for (int ai = 0; ai < 2; ++ai) {
            u32x4 gv[4][2];
#pragma unroll
            for (int m = 0; m < 4; ++m)
#pragma unroll
                for (int bj = 0; bj < 2; ++bj) gv[m][bj] = *(const u32x4*)(P + (size_t)(row0 + ai * 128 + m * 16) * NP + PC_GATE + 2 * 2048 + u.pn * 256 + bj * 128 + wc * 32 + 8 * fq);
#pragma unroll
            for (int m = 0; m < 4; ++m) {
                const int row = row0 + ai * 128 + m * 16;
#pragma unroll
                for (int bj = 0; bj < 2; ++bj) {
                    const int col = u.pn * 256 + bj * 128 + wc * 32 + 8 * fq;
                    const u32x4 g = gv[m][bj];
                    const f32x4 v0 = acc[ai][bj][m][0] * (f32x4){fmaxf(bflo(g.x), GMIN), fmaxf(bfhi(g.x), GMIN), fmaxf(bflo(g.y), GMIN), fmaxf(bfhi(g.y), GMIN)};
                    const f32x4 v1 = acc[ai][bj][m][1] * (f32x4){fmaxf(bflo(g.z), GMIN), fmaxf(bfhi(g.z), GMIN), fmaxf(bflo(g.w), GMIN), fmaxf(bfhi(g.w), GMIN)};
                    u32x4 w; w.x = cvtpk(v0[0], v0[1]); w.y = cvtpk(v0[2], v0[3]); w.z = cvtpk(v1[0], v1[1]); w.w = cvtpk(v1[2], v1[3]);
                    *(u32x4*)(Mb + (size_t)row * DM + col) = w;
                }
            }
        }
    }
};

struct EpiE {
    static constexpr bool HAS_MID = false;
    const float* xin; float* xout; bf16_t* xb; float* ssq; bool dry;
    __device__ __forceinline__ void operator()(const f32x4 (&acc)[2][2][4][2], const GUnit& u, int wr, int wc, int fr, int fq) const {
        const int row0 = u.pm * 256 + wr * 64 + fr;
#pragma unroll
        for (int ai = 0; ai < 2; ++ai)
#pragma unroll
            for (int m = 0; m < 4; ++m) {
                const int row = row0 + ai * 128 + m * 16; float sq = 0.f;
#pragma unroll
                for (int bj = 0; bj < 2; ++bj) {
                    const int col = u.pn * 256 + bj * 128 + wc * 32 + 8 * fq;
                    const float* xp = xin + (size_t)row * DM + col;
                    const f32x4 v0 = acc[ai][bj][m][0] + *(const f32x4*)xp, v1 = acc[ai][bj][m][1] + *(const f32x4*)(xp + 4);
                    float* op = xout + (size_t)row * DM + col;
                    *(f32x4*)op = v0; *(f32x4*)(op + 4) = v1;
                    if (ssq) {
                        sq += (v0[0] * v0[0] + v0[1] * v0[1]) + (v0[2] * v0[2] + v0[3] * v0[3]) + (v1[0] * v1[0] + v1[1] * v1[1]) + (v1[2] * v1[2] + v1[3] * v1[3]);
                        u32x4 w; w.x = cvtpk(v0[0], v0[1]); w.y = cvtpk(v0[2], v0[3]); w.z = cvtpk(v1[0], v1[1]); w.w = cvtpk(v1[2], v1[3]);
                        *(u32x4*)(xb + (size_t)row * DM + col) = w;
                    }
                }
                if (ssq && !dry) { sq += __shfl_xor(sq, 16); sq += __shfl_xor(sq, 32); if (fq == 0) atomicAdd(ssq + row, sq); }
            }
    }
};

__device__ __forceinline__ int tr_srcmap(int kind, int n);
__device__ __forceinline__ void transpose_one(const float* W, int ldw, int Ndst, bf16_t* WT, int ldd, int kofs, const float* kscale, int kind,
                                              LAS float* scr, int it, int lane) {
    const int nblk = Ndst / 32;
    const int kb = it / nblk, nb = it % nblk, k0 = 64 * kb, n0 = 32 * nb;
    const int sc = tr_srcmap(kind, n0 + (lane & 31));
    float tv[32];
    const float* wp = W + (size_t)(k0 + (lane >> 5)) * ldw + (sc >= 0 ? sc : 0);
#pragma unroll
    for (int i = 0; i < 32; ++i) tv[i] = __builtin_nontemporal_load(wp + (size_t)(2 * i) * ldw);
    if (kscale) {
#pragma unroll
        for (int i = 0; i < 32; ++i) tv[i] *= kscale[k0 + 2 * i + (lane >> 5)];
    }
#pragma unroll
    for (int i = 0; i < 32; ++i) scr[(2 * i + (lane >> 5)) * 33 + (lane & 31)] = (sc >= 0) ? tv[i] : 0.f;
    LDS_WAIT(); asm volatile("" ::: "memory");
    const int c = lane & 7;
#pragma unroll
    for (int j = 0; j < 4; ++j) { const int n = (lane >> 3) + 8 * j; const LAS float* s = scr + (8 * c) * 33 + n;
        u32x4 o; o.x = pk2(s[0 * 33], s[1 * 33]); o.y = pk2(s[2 * 33], s[3 * 33]); o.z = pk2(s[4 * 33], s[5 * 33]); o.w = pk2(s[6 * 33], s[7 * 33]);
        *(u32x4*)(WT + (size_t)(n0 + n) * ldd + kofs + k0 + 8 * c) = o; }
    LDS_WAIT(); asm volatile("" ::: "memory");
}
struct MapId { __device__ __forceinline__ int operator()(int n) const { return n; } };
struct MapIn { __device__ __forceinline__ int operator()(int n) const {
    if (n < 3072) return n;
    if (n < 3328) return (n - 3072 < 64) ? n : -1;
    if (n < 4352) return n - 3328 + 3136;
    if (n < 5888) return n - 4352 + 4160;
    if (n < 6144) return (n - 5888 < 128) ? 5696 + (n - 5888) : -1;
    if (n < 6656) return n - 6144 + 5824;
    return n - 6656 + 6336; } };
struct MapUq { __device__ __forceinline__ int operator()(int n) const {
    const int h = n >> 8, p = n & 255;
    if (p < 128) return h * 192 + p;
    if (p < 192) { const int j = (p - 128) >> 3, e = (p - 128) & 7; return h * 192 + 128 + (e >> 2) * 32 + 4 * j + (e & 3); }
    return -1; } };

__device__ __forceinline__ int tr_srcmap(int kind, int n) { return kind == 1 ? MapIn()(n) : (kind == 2 ? MapUq()(n) : n); }

__device__ __forceinline__ void sincos_acc(float ang, float& sn, float& cs) {
    const double x = (double)ang;
    const double rev = x * 0.15915494309189535;
    const double fr = rev - __builtin_rint(rev);
    const double r = fr * 6.283185307179586476925;
    const double r2 = r * r;
    double ts = 1.0, ss = 1.0, tc = 1.0, sc2 = 1.0;
#pragma unroll
    for (int k = 1; k <= 13; ++k) { tc = -tc * r2 * (1.0 / (double)((2 * k - 1) * (2 * k))); sc2 += tc; ts = -ts * r2 * (1.0 / (double)((2 * k) * (2 * k + 1))); ss += ts; }
    sn = (float)(r * ss); cs = (float)sc2;
}

__device__ __forceinline__ int crow(int r, int hi) { return (r & 3) + 8 * (r >> 2) + 4 * hi; }
__device__ __forceinline__ int v_st(int k, int c) { const int kk = (k & ~0xC) | ((k & 4) << 1) | ((k & 8) >> 1); return ((kk >> 3) * 4 + (c >> 5)) * 512 + ((kk & 7) * 32 + (c & 31)) * 2; }
__device__ __forceinline__ int v_rd_base(int lane) { return ((lane & 3) << 3) | (((lane >> 2) & 3) << 6) | (((lane >> 4) & 1) << 5) | (((lane >> 5) & 1) << 8); }
constexpr int v_rd_off(int d0, int ks, int half) { return d0 * 512 + ks * 4096 + half * 2048; }
template <int OFF> __device__ __forceinline__ s16x4 tr_read(int vb) {
    s16x4 r; asm volatile("ds_read_b64_tr_b16 %0, %1 offset:%2" : "=&v"(r) : "v"(vb), "i"(OFF) : "memory"); return r;
}
template <int D0> __device__ __forceinline__ void pv_one(f32x16& od, int vb, bf16x8 pa0, bf16x8 pa1, bf16x8 pa2, bf16x8 pa3) {
    const s16x4 l0 = tr_read<v_rd_off(D0, 0, 0)>(vb), h0 = tr_read<v_rd_off(D0, 0, 1)>(vb), l1 = tr_read<v_rd_off(D0, 1, 0)>(vb), h1 = tr_read<v_rd_off(D0, 1, 1)>(vb);
    const s16x4 l2 = tr_read<v_rd_off(D0, 2, 0)>(vb), h2 = tr_read<v_rd_off(D0, 2, 1)>(vb), l3 = tr_read<v_rd_off(D0, 3, 0)>(vb), h3 = tr_read<v_rd_off(D0, 3, 1)>(vb);
    asm volatile("s_waitcnt lgkmcnt(0)" ::: "memory"); __builtin_amdgcn_sched_barrier(0);
#define PK(L, H) (bf16x8){L[0], L[1], L[2], L[3], H[0], H[1], H[2], H[3]}
    od = __builtin_amdgcn_mfma_f32_32x32x16_bf16(pa0, PK(l0, h0), od, 0, 0, 0);
    od = __builtin_amdgcn_mfma_f32_32x32x16_bf16(pa1, PK(l1, h1), od, 0, 0, 0);
    od = __builtin_amdgcn_mfma_f32_32x32x16_bf16(pa2, PK(l2, h2), od, 0, 0, 0);
    od = __builtin_amdgcn_mfma_f32_32x32x16_bf16(pa3, PK(l3, h3), od, 0, 0, 0);
#undef PK
}
#define PK4(P, BASE, OUT) do { unsigned a0 = cvtpk(P[BASE + 0], P[BASE + 1]), a1 = cvtpk(P[BASE + 2], P[BASE + 3]);   \
    unsigned b0 = cvtpk(P[BASE + 4], P[BASE + 5]), b1 = cvtpk(P[BASE + 6], P[BASE + 7]);                              \
    auto r0 = __builtin_amdgcn_permlane32_swap(a0, b0, false, false); auto r1 = __builtin_amdgcn_permlane32_swap(a1, b1, false, false); \
    u32x4 w_ = {r0[0], r1[0], r0[1], r1[1]}; OUT = __builtin_bit_cast(bf16x8, w_); } while (0)

__device__ __forceinline__ void sb_block(f32x16& Z, int keyb, int rowi, int hi, float R, float& E) {
#pragma unroll
    for (int g = 3; g >= 0; --g) {
        float lf[4], zz[4]; bool vd[4];
#pragma unroll
        for (int q = 0; q < 4; ++q) {
            const float z = Z[4 * g + q] * SCALE_SB; const bool valid = (keyb + 8 * g + q) < rowi;
            const float sp = fmaxf(z, 0.f) + __logf(1.f + __expf(-fabsf(z)));
            lf[q] = valid ? -sp : 0.f; zz[q] = z; vd[q] = valid;
        }
        const float ex3 = 0.f, ex2 = lf[3], ex1 = ex2 + lf[2], ex0 = ex1 + lf[1], G = ex0 + lf[0];
        const float Gp = __shfl_xor(G, 32);
        const float off = R + E + (hi == 0 ? Gp : 0.f);
        Z[4 * g + 0] = vd[0] ? __expf(zz[0] + lf[0] + off + ex0) : 0.f;
        Z[4 * g + 1] = vd[1] ? __expf(zz[1] + lf[1] + off + ex1) : 0.f;
        Z[4 * g + 2] = vd[2] ? __expf(zz[2] + lf[2] + off + ex2) : 0.f;
        Z[4 * g + 3] = vd[3] ? __expf(zz[3] + lf[3] + off + ex3) : 0.f;
        E += G + Gp;
    }
}

template <int DQK, bool SBM>
__device__ __forceinline__ void attn_unit(LAS unsigned char* lds, const bf16_t* Qp, int ldq, const bf16_t* Kp, int ldk, const bf16_t* Vp, int ldv,
                                          const bf16_t* Gp, int ldg, bf16_t* Op, int ldo, int qb) {
    constexpr int KROW = DQK * 2, KT_BYTES = 64 * KROW, VT_BYTES = 64 * 128 * 2, NKP = DQK / 64, ND0 = DQK / 16, PPR = DQK / 8;
    int tid = threadIdx.x; asm volatile("" : "+v"(tid));
    const int wid = __builtin_amdgcn_readfirstlane(tid >> 6), lane = tid & 63, r32 = lane & 31, hi = lane >> 5;
    LAS unsigned char* Kl = lds; LAS unsigned char* Vl = lds + 3 * KT_BYTES;
    LAS float* wscr = (LAS float*)(lds + LDS_SCR + 9216) + wid * 64;
    LAS int* flags = (LAS int*)(lds + LDS_SCR + 11264);
    bf16x8 qr[ND0];
    { const bf16_t* Qw = Qp + (size_t)(wid * 32 + r32) * ldq + hi * 8;
#pragma unroll
      for (int d0 = 0; d0 < ND0; ++d0) qr[d0] = *(const bf16x8*)(Qw + d0 * 16); }
    f32x16 o[4];
#pragma unroll
    for (int d = 0; d < 4; ++d)
#pragma unroll
        for (int r = 0; r < 16; ++r) o[d][r] = 0.f;
    float m_reg = -1e30f, l_reg = 0.f, R = 0.f;
    const int NT = 4 * qb + 4;
    const int vb0 = (int)(uintptr_t)Vl + v_rd_base(lane);
    int koff[NKP], voff[2];
#pragma unroll
    for (int i = 0; i < NKP; ++i) { const int q = (wid * NKP + i) * 64 + lane, row = q / PPR, c16 = q % PPR; koff[i] = row * ldk + ((c16 ^ (row & 7)) * 8); }
#pragma unroll
    for (int i = 0; i < 2; ++i) { const int q = (wid * 2 + i) * 64 + lane, st = q >> 5, wi = q & 31, kk = (st >> 2) * 8 + (wi >> 2), c = (st & 3) * 32 + (wi & 3) * 8;
        const int k = (kk & ~0xC) | ((kk & 4) << 1) | ((kk & 8) >> 1); voff[i] = k * ldv + c; }
#define ISSUE(kt, b) do { _Pragma("unroll") for (int i = 0; i < NKP; ++i) __builtin_amdgcn_global_load_lds((const unsigned*)(Kp + (size_t)(kt) * 64 * ldk + koff[i]), \
            (LAS unsigned*)(Kl + (b) * KT_BYTES + (wid * NKP + i) * 1024), 16, 0, 0); \
        _Pragma("unroll") for (int i = 0; i < 2; ++i) __builtin_amdgcn_global_load_lds((const unsigned*)(Vp + (size_t)(kt) * 64 * ldv + voff[i]), \
            (LAS unsigned*)(Vl + (b) * VT_BYTES + (wid * 2 + i) * 1024), 16, 0, 0); } while (0)
    ISSUE(SBM ? NT - 1 : 0, 0);
    if (NT > 1) { ISSUE(SBM ? NT - 2 : 1, 1); if constexpr (NKP == 3) asm volatile("s_waitcnt vmcnt(5)" ::: "memory"); else asm volatile("s_waitcnt vmcnt(4)" ::: "memory"); }
    else asm volatile("s_waitcnt vmcnt(0)" ::: "memory");
    __syncthreads();
    const int rowi = 256 * qb + 32 * wid + r32;
    for (int it = 0; it < NT; ++it) {
        const int kt = SBM ? NT - 1 - it : it, buf = it % 3;
        if (it + 2 < NT) ISSUE(SBM ? kt - 2 : kt + 2, (it + 2) % 3);
        const bool active = SBM ? (64 * kt <= 256 * qb + 32 * wid + 30) : (kt <= 4 * qb + (wid >> 1));
        if (active) {
            f32x16 p0, p1;
#pragma unroll
            for (int r = 0; r < 16; ++r) { p0[r] = 0.f; p1[r] = 0.f; }
            LAS unsigned char* Kb = Kl + buf * KT_BYTES;
#pragma unroll
            for (int dl = 0; dl < 4; ++dl) {
                LAS unsigned char* kb_dl = Kb + r32 * KROW + ((dl * 32 + hi * 16) ^ ((r32 & 7) << 4));
#pragma unroll
                for (int dh = 0; dh < ND0 / 4; ++dh) {
                    const bf16x8 b0 = *(const LAS bf16x8*)(kb_dl + dh * 128);
                    const bf16x8 b1 = *(const LAS bf16x8*)(kb_dl + dh * 128 + 32 * KROW);
                    p0 = __builtin_amdgcn_mfma_f32_32x32x16_bf16(b0, qr[4 * dh + dl], p0, 0, 0, 0);
                    p1 = __builtin_amdgcn_mfma_f32_32x32x16_bf16(b1, qr[4 * dh + dl], p1, 0, 0, 0); }
                __builtin_amdgcn_sched_barrier(0); }
            if constexpr (SBM) {
                float E = 0.f;
                sb_block(p1, kt * 64 + 32 + 4 * hi, rowi, hi, R, E);
                sb_block(p0, kt * 64 + 4 * hi, rowi, hi, R, E);
                R += E;
            } else {
                float pmax = p0[0];
#pragma unroll
                for (int r = 1; r < 16; ++r) pmax = fmaxf(pmax, p0[r]);
#pragma unroll
                for (int r = 0; r < 16; ++r) pmax = fmaxf(pmax, p1[r]);
                pmax = fmaxf(pmax, __shfl_xor(pmax, 32));
                float mn = m_reg, alpha = 1.f;
                if (!__all(pmax - m_reg <= 8.f)) { mn = fmaxf(m_reg, pmax); alpha = __builtin_amdgcn_exp2f(m_reg - mn); m_reg = mn; }
                float ps = 0.f;
#pragma unroll
                for (int r = 0; r < 16; ++r) { p0[r] = __builtin_amdgcn_exp2f(p0[r] - mn); ps += p0[r]; }
#pragma unroll
                for (int r = 0; r < 16; ++r) { p1[r] = __builtin_amdgcn_exp2f(p1[r] - mn); ps += p1[r]; }
                ps += __shfl_xor(ps, 32);
                l_reg = l_reg * alpha + ps;
                if (__any(alpha < 1.f)) {
                    if (hi == 0) wscr[r32] = alpha;
                    LDS_WAIT();
#pragma unroll
                    for (int r = 0; r < 16; ++r) { const float al = wscr[crow(r, hi)];
#pragma unroll
                        for (int d = 0; d < 4; ++d) o[d][r] *= al; }
                }
            }
            bf16x8 pa0, pa1, pa2, pa3;
            PK4(p0, 0, pa0); PK4(p0, 8, pa1); PK4(p1, 0, pa2); PK4(p1, 8, pa3);
            const int vb = vb0 + buf * VT_BYTES;
            pv_one<0>(o[0], vb, pa0, pa1, pa2, pa3); pv_one<1>(o[1], vb, pa0, pa1, pa2, pa3); pv_one<2>(o[2], vb, pa0, pa1, pa2, pa3); pv_one<3>(o[3], vb, pa0, pa1, pa2, pa3);
        }
        if constexpr (SBM) { const int dn = __all(R < -104.f) ? 1 : 0; if (lane == 0) flags[(it & 1) * 8 + wid] = dn; }
        if (it + 2 < NT) { if constexpr (NKP == 3) asm volatile("s_waitcnt vmcnt(5)" ::: "memory"); else asm volatile("s_waitcnt vmcnt(4)" ::: "memory"); }
        else asm volatile("s_waitcnt vmcnt(0)" ::: "memory");
        __syncthreads();
        if constexpr (SBM) {
            int alld = 1;
#pragma unroll
            for (int w = 0; w < 8; ++w) alld &= flags[(it & 1) * 8 + w];
            if (alld) { asm volatile("s_waitcnt vmcnt(0)" ::: "memory"); break; }
        }
    }
    if constexpr (SBM) __syncthreads();
    if constexpr (!SBM) { if (hi == 0) wscr[r32] = l_reg; LDS_WAIT(); }
    LAS float* ot = (LAS float*)lds + wid * (32 * 132);
#pragma unroll
    for (int r = 0; r < 16; ++r) { const int orow = crow(r, hi);
        float rl = 1.f; if constexpr (!SBM) rl = __builtin_amdgcn_rcpf(wscr[orow]);
#pragma unroll
        for (int d0 = 0; d0 < 4; ++d0) ot[orow * 132 + d0 * 32 + r32] = o[d0][r] * rl; }
    LDS_WAIT();
    { const int er = lane >> 4, ec = (lane & 15) * 8;
      const bf16_t* Gw = Gp + (size_t)(wid * 32 + er) * ldg + ec; bf16_t* Ow = Op + (size_t)(wid * 32 + er) * ldo + ec;
      u32x4 gv[8];
#pragma unroll
      for (int ps = 0; ps < 8; ++ps) gv[ps] = *(const u32x4*)(Gw + (size_t)(ps * 4) * ldg);
#pragma unroll
      for (int ps = 0; ps < 8; ++ps) {
          const f32x4 a0 = *(const LAS f32x4*)(ot + (ps * 4 + er) * 132 + ec), a1 = *(const LAS f32x4*)(ot + (ps * 4 + er) * 132 + ec + 4);
          const u32x4 g = gv[ps];
          u32x4 w; w.x = cvtpk(a0[0] * bflo(g.x), a0[1] * bfhi(g.x)); w.y = cvtpk(a0[2] * bflo(g.y), a0[3] * bfhi(g.y));
          w.z = cvtpk(a1[0] * bflo(g.z), a1[1] * bfhi(g.z)); w.w = cvtpk(a1[2] * bflo(g.w), a1[3] * bfhi(g.w));
          *(u32x4*)(Ow + (size_t)(ps * 4) * ldo) = w;
          __builtin_amdgcn_sched_barrier(0);
      } }
    __syncthreads();
#undef ISSUE
}

__device__ __forceinline__ float rowsum16(float x) {
    x += __builtin_bit_cast(float, __builtin_amdgcn_update_dpp(0, __builtin_bit_cast(int, x), 0x128, 0xf, 0xf, false));
    x += __builtin_bit_cast(float, __builtin_amdgcn_update_dpp(0, __builtin_bit_cast(int, x), 0x124, 0xf, 0xf, false));
    x += __builtin_bit_cast(float, __builtin_amdgcn_update_dpp(0, __builtin_bit_cast(int, x), 0x122, 0xf, 0xf, false));
    x += __builtin_bit_cast(float, __builtin_amdgcn_update_dpp(0, __builtin_bit_cast(int, x), 0x121, 0xf, 0xf, false));
    return x;
}

__device__ __forceinline__ float wsum64(float x) {
    x = rowsum16(x);
    const int xi = __builtin_bit_cast(int, x);
    const float r0 = __builtin_bit_cast(float, __builtin_amdgcn_readlane(xi, 0)), r1 = __builtin_bit_cast(float, __builtin_amdgcn_readlane(xi, 16));
    const float r2 = __builtin_bit_cast(float, __builtin_amdgcn_readlane(xi, 32)), r3 = __builtin_bit_cast(float, __builtin_amdgcn_readlane(xi, 48));
    return (r0 + r1) + (r2 + r3);
}

template <int NB>
__device__ __forceinline__ void rw_finaliseN(int it0, int stride, const float* gng, const float* gnb, const float* rk, const float* OSC, const float* SCN, const bf16_t* P, bf16_t* ycat) {
    int tl = threadIdx.x; asm volatile("" : "+v"(tl)); const int lane = tl & 63;
    float ov[NB], rr[NB], kk_[NB], vv_[NB], gg[NB];
#pragma unroll
    for (int q = 0; q < NB; ++q) { const int it = it0 + q * stride, t = it >> 3, h = it & 7, b = t >> 12, s = t & (S - 1), ch = h * 64 + lane;
        ov[q] = OSC[(size_t)t * 512 + ch];
        const float* sp = SCN + ((size_t)(b * 8 + h) * S + s) * 384 + lane;
        rr[q] = sp[0]; kk_[q] = sp[128]; vv_[q] = sp[320];
        gg[q] = bf2f(P[(size_t)t * NP + PC_RG + ch]); }
#pragma unroll
    for (int q = 0; q < NB; ++q) { const int it = it0 + q * stride, t = it >> 3, h = it & 7, ch = h * 64 + lane;
        const float mu = wsum64(ov[q]) * (1.f / 64.f), d = ov[q] - mu, var = wsum64(d * d) * (1.f / 64.f);
        const float y = d * rsqrtf(var + 64e-5f) * gng[ch] + gnb[ch];
        const float bonus = wsum64(rr[q] * kk_[q] * rk[ch]) * vv_[q];
        ycat[(size_t)t * DM + 1536 + ch] = (bf16_t)f2bf((y + bonus) * gg[q]); }
}

struct RwParams { const float* PRW; const float* mu; const float* w0; const float* w_up; const float* a0; const float* a_up; const float* k_k; const float* k_a; float* SCN; };

__device__ __forceinline__ void rw_prep(LAS unsigned char* lds, const RwParams& q, int tile) {
    int tid = threadIdx.x; asm volatile("" : "+v"(tid));
    const int lane = tid & 63, h = tid >> 6, t0 = tile * 32;
    LAS float* tw = (LAS float*)lds; LAS float* ta = tw + 2048;
#pragma unroll
    for (int e = 0; e < 8; ++e) { const int idx = tid + 512 * e, tk = idx >> 7, jj = idx & 127, t = t0 + tk;
        const float cur = q.PRW[(size_t)t * PRW_LD + 1536 + jj];
        const float prev = ((t & (S - 1)) == 0) ? 0.f : q.PRW[(size_t)(t - 1) * PRW_LD + 1536 + jj];
        const float sh = cur + q.mu[1536 + jj] * (prev - cur);
        if (jj < 64) tw[tk * 64 + jj] = tanhf(sh); else ta[tk * 64 + jj - 64] = sh; }
    __syncthreads();
    float aw[32], aa[32];
#pragma unroll
    for (int k = 0; k < 32; ++k) { aw[k] = 0.f; aa[k] = 0.f; }
    for (int j0 = 0; j0 < 64; j0 += 4) {
        float wu[4], au[4];
#pragma unroll
        for (int e = 0; e < 4; ++e) { wu[e] = q.w_up[(j0 + e) * 512 + tid]; au[e] = q.a_up[(j0 + e) * 512 + tid]; }
#pragma unroll
        for (int k = 0; k < 32; ++k) { const f32x4 x = *(const LAS f32x4*)(tw + k * 64 + j0), y = *(const LAS f32x4*)(ta + k * 64 + j0);
            aw[k] += (x[0] * wu[0] + x[1] * wu[1]) + (x[2] * wu[2] + x[3] * wu[3]);
            aa[k] += (y[0] * au[0] + y[1] * au[1]) + (y[2] * au[2] + y[3] * au[3]); }
    }
    const float w0c = q.w0[tid], a0c = q.a0[tid], kkc = q.k_k[tid], kac = q.k_a[tid], mur = q.mu[tid], muk = q.mu[512 + tid], muv = q.mu[1024 + tid];
    float pr = 0.f, pk = 0.f, pv = 0.f;
    if ((t0 & (S - 1)) != 0) { const float* pp = q.PRW + (size_t)(t0 - 1) * PRW_LD; pr = pp[tid]; pk = pp[512 + tid]; pv = pp[1024 + tid]; }
    const int b = t0 >> 12, s0 = t0 & (S - 1);
    float* dst = q.SCN + ((size_t)(b * 8 + h) * S + s0) * 384 + lane;
#pragma unroll
    for (int k = 0; k < 32; ++k) {
        const float* cp = q.PRW + (size_t)(t0 + k) * PRW_LD;
        const float cr = cp[tid], ck = cp[512 + tid], cv = cp[1024 + tid];
        const float rs_ = cr + mur * (pr - cr), ks_ = ck + muk * (pk - ck), vs_ = cv + muv * (pv - cv);
        pr = cr; pk = ck; pv = cv;
        const float uu = -(w0c + aw[k]);
        const float spl = fmaxf(uu, 0.f) + log1pf(expf(-fabsf(uu)));
        const float decay = expf(-expf(-spl - 0.5f));
        const float a = 1.f / (1.f + expf(-(a0c + aa[k])));
        float kk = ks_ * kkc; const float n2 = wsum64(kk * kk); kk = kk / fmaxf(sqrtf(n2), 1e-12f);
        const float kmod = ks_ * (1.f + (a - 1.f) * kac);
        float* d = dst + (size_t)k * 384;
        d[0] = rs_; d[64] = decay; d[128] = kmod; d[192] = -kk; d[256] = kk * a; d[320] = vs_;
    }
    __syncthreads();
}

__device__ __forceinline__ void rw_prep_mfma(LAS unsigned char* lds, const RwParams& q, int tile) {
    int tid = threadIdx.x; asm volatile("" : "+v"(tid));
    const int lane = tid & 63, h = __builtin_amdgcn_readfirstlane(tid >> 6), t0 = tile * 32, l16 = lane & 15, lq = lane >> 4;
    constexpr int TS = 65;
    LAS float* tw = (LAS float*)lds; LAS float* ta = tw + 32 * TS;
#pragma unroll
    for (int e = 0; e < 8; ++e) { const int idx = tid + 512 * e, tk = idx >> 7, jj = idx & 127, t = t0 + tk;
        const float cur = q.PRW[(size_t)t * PRW_LD + 1536 + jj];
        const float prev = ((t & (S - 1)) == 0) ? 0.f : q.PRW[(size_t)(t - 1) * PRW_LD + 1536 + jj];
        const float sh = cur + q.mu[1536 + jj] * (prev - cur);
        if (jj < 64) { const float e2 = __expf(-2.f * fabsf(sh)), th = (1.f - e2) * __builtin_amdgcn_rcpf(1.f + e2); tw[tk * TS + jj] = sh < 0.f ? -th : th; }
        else ta[tk * TS + jj - 64] = sh; }
    __syncthreads();
    f32x4 accW[2][4], accA[2][4];
#pragma unroll
    for (int tb = 0; tb < 2; ++tb)
#pragma unroll
        for (int cb = 0; cb < 4; ++cb) { accW[tb][cb] = (f32x4){0.f, 0.f, 0.f, 0.f}; accA[tb][cb] = (f32x4){0.f, 0.f, 0.f, 0.f}; }
    const float* wu = q.w_up + h * 64 + l16; const float* au = q.a_up + h * 64 + l16;
#pragma unroll 2
    for (int ks = 0; ks < 16; ++ks) {
        const int kk = 4 * ks + lq;
        float aW[2], aA[2], bW[4], bA[4];
#pragma unroll
        for (int tb = 0; tb < 2; ++tb) { aW[tb] = tw[(tb * 16 + l16) * TS + kk]; aA[tb] = ta[(tb * 16 + l16) * TS + kk]; }
#pragma unroll
        for (int cb = 0; cb < 4; ++cb) { bW[cb] = wu[kk * 512 + cb * 16]; bA[cb] = au[kk * 512 + cb * 16]; }
#pragma unroll
        for (int tb = 0; tb < 2; ++tb)
#pragma unroll
            for (int cb = 0; cb < 4; ++cb) { accW[tb][cb] = __builtin_amdgcn_mfma_f32_16x16x4f32(aW[tb], bW[cb], accW[tb][cb], 0, 0, 0);
                                             accA[tb][cb] = __builtin_amdgcn_mfma_f32_16x16x4f32(aA[tb], bA[cb], accA[tb][cb], 0, 0, 0); }
    }
    const int b = t0 >> 12, s0 = t0 & (S - 1);
#pragma unroll
    for (int tb = 0; tb < 2; ++tb) {
        const int tkb = tb * 16 + 4 * lq;
        const bool first = (((t0 + tkb) & (S - 1)) == 0);
        float kkv[4][4], av[4][4];
#pragma unroll
        for (int cb = 0; cb < 4; ++cb) {
            const int c = h * 64 + cb * 16 + l16;
            const float w0c = q.w0[c], a0c = q.a0[c], kkc = q.k_k[c], kac = q.k_a[c], mur = q.mu[c], muk = q.mu[512 + c], muv = q.mu[1024 + c];
            float pr = 0.f, pk = 0.f, pv = 0.f;
            if (!first) { const float* pp = q.PRW + (size_t)(t0 + tkb - 1) * PRW_LD; pr = pp[c]; pk = pp[512 + c]; pv = pp[1024 + c]; }
#pragma unroll
            for (int r = 0; r < 4; ++r) {
                const float* cp = q.PRW + (size_t)(t0 + tkb + r) * PRW_LD;
                const float cr = cp[c], ck = cp[512 + c], cv = cp[1024 + c];
                const float rs_ = cr + mur * (pr - cr), ks_ = ck + muk * (pk - ck), vs_ = cv + muv * (pv - cv);
                pr = cr; pk = ck; pv = cv;
                const float uu = -(w0c + accW[tb][cb][r]);
                const float spl = fmaxf(uu, 0.f) + __logf(1.f + __expf(-fabsf(uu)));
                const float decay = __expf(-__expf(-spl - 0.5f));
                const float a = __builtin_amdgcn_rcpf(1.f + __expf(-(a0c + accA[tb][cb][r])));
                kkv[cb][r] = ks_ * kkc; av[cb][r] = a;
                float* d = q.SCN + ((size_t)(b * 8 + h) * S + s0 + tkb + r) * 384 + cb * 16 + l16;
                d[0] = rs_; d[64] = decay; d[128] = ks_ * (1.f + (a - 1.f) * kac); d[320] = vs_;
            }
        }
#pragma unroll
        for (int r = 0; r < 4; ++r) {
            float n2 = (kkv[0][r] * kkv[0][r] + kkv[1][r] * kkv[1][r]) + (kkv[2][r] * kkv[2][r] + kkv[3][r] * kkv[3][r]);
            n2 = rowsum16(n2);
            const float inv = __builtin_amdgcn_rsqf(fmaxf(n2, 1e-24f));
            float* d = q.SCN + ((size_t)(b * 8 + h) * S + s0 + tkb + r) * 384 + l16;
#pragma unroll
            for (int cb = 0; cb < 4; ++cb) { const float kn = kkv[cb][r] * inv; d[192 + cb * 16] = -kn; d[256 + cb * 16] = kn * av[cb][r]; }
        }
    }
    __syncthreads();
}

__device__ __forceinline__ void rw_scan(LAS unsigned char* lds, const float* SCN, float* OSC, int sb) {
    int tid = threadIdx.x; asm volatile("" : "+v"(tid));
    const int wid = __builtin_amdgcn_readfirstlane(tid >> 6), lane = tid & 63;
    const int bh = sb >> 2, rg = sb & 3, b = bh >> 3, h = bh & 7;
    const float* src = SCN + (size_t)bh * S * 384;
    constexpr int CH = 16, CHF = CH * 384, NCH = S / CH;
    LAS float* bufs = (LAS float*)lds;
    LAS float* pb = bufs + 4 * CHF;
    const int rowl = 4 * wid + (lane >> 4), cg4 = (lane & 15) * 4;
    f32x4 s = (f32x4){0.f, 0.f, 0.f, 0.f};
#define SCAN_ISSUE(ch) do { const float* sp_ = src + (size_t)(ch) * CHF + lane * 4; LAS float* dp_ = bufs + ((ch) & 3) * CHF; \
        _Pragma("unroll") for (int i = 0; i < 12; ++i) { const int j = (wid - 4) * 12 + i; \
            __builtin_amdgcn_global_load_lds((const unsigned*)(sp_ + j * 256), (LAS unsigned*)(dp_ + j * 256), 16, 0, 0); } } while (0)
    if (wid == 4 || wid == 5) { SCAN_ISSUE(0); SCAN_ISSUE(1); SCAN_ISSUE(2); asm volatile("s_waitcnt vmcnt(24)" ::: "memory"); }
    __syncthreads();
    for (int c = 0; c < NCH; ++c) {
        if (wid < 4) {
            const LAS float* bp = bufs + (c & 3) * CHF + cg4;
            const LAS float* vp = bufs + (c & 3) * CHF + 320 + 16 * rg + rowl;
            LAS float* pp = pb + (c & 1) * 4096 + wid * 64 + lane;
            f32x4 r4[3], w4[3], k4[3], a4[3], b4[3]; float vv[3];
            const unsigned ba = (unsigned)(uintptr_t)bp, va = (unsigned)(uintptr_t)vp;
#define LRD128(dst, addr, off) asm volatile("ds_read_b128 %0, %1 offset:%2" : "=v"(dst) : "v"(addr), "i"(off))
#define LRD32(dst, addr, off) asm volatile("ds_read_b32 %0, %1 offset:%2" : "=v"(dst) : "v"(addr), "i"(off))
#define RD_STEP(set, stp) do { LRD128(r4[set], ba, (stp) * 1536); LRD128(w4[set], ba, (stp) * 1536 + 256); LRD128(k4[set], ba, (stp) * 1536 + 512); \
        LRD128(a4[set], ba, (stp) * 1536 + 768); LRD128(b4[set], ba, (stp) * 1536 + 1024); LRD32(vv[set], va, (stp) * 1536); } while (0)
#define WAITK(n, set) asm volatile("s_waitcnt lgkmcnt(" #n ")" : "+v"(r4[set]), "+v"(w4[set]), "+v"(k4[set]), "+v"(a4[set]), "+v"(b4[set]), "+v"(vv[set]))
#define STEP_BODY(st, cu) do { const f32x4 sa4 = s * a4[cu]; float sa = (sa4[0] + sa4[1]) + (sa4[2] + sa4[3]); \
        const f32x4 t1 = s * w4[cu] + vv[cu] * k4[cu]; sa = rowsum16(sa); s = t1 + sa * b4[cu]; \
        const f32x4 o4 = s * r4[cu]; pp[(st) * 256] = (o4[0] + o4[1]) + (o4[2] + o4[3]); } while (0)
#define STEP(st) do { RD_STEP(((st) + 2) % 3, (st) + 2); WAITK(12, (st) % 3); STEP_BODY(st, (st) % 3); } while (0)
            RD_STEP(0, 0); RD_STEP(1, 1);
            STEP(0); STEP(1); STEP(2); STEP(3); STEP(4); STEP(5); STEP(6); STEP(7); STEP(8); STEP(9); STEP(10); STEP(11); STEP(12); STEP(13);
            WAITK(6, 14 % 3); STEP_BODY(14, 14 % 3);
            WAITK(0, 15 % 3); STEP_BODY(15, 15 % 3);
#undef STEP
#undef STEP_BODY
#undef WAITK
#undef RD_STEP
#undef LRD32
#undef LRD128
        } else if (wid < 6) {
            if (c + 3 < NCH) { SCAN_ISSUE(c + 3); asm volatile("s_waitcnt vmcnt(24)" ::: "memory"); }
            else if (c + 2 < NCH) asm volatile("s_waitcnt vmcnt(12)" ::: "memory");
            else asm volatile("s_waitcnt vmcnt(0)" ::: "memory");
        } else if (c > 0) {
            const int lt = tid - 384;
#pragma unroll
            for (int e = 0; e < 2; ++e) { const int oi = lt * 2 + e, st = oi >> 4, rl = oi & 15;
                const LAS f32x4* p4 = (const LAS f32x4*)(pb + ((c - 1) & 1) * 4096 + oi * 16);
                const f32x4 x0 = p4[0], x1 = p4[1], x2 = p4[2], x3 = p4[3];
                const f32x4 t = (x0 + x1) + (x2 + x3);
                OSC[((size_t)b * S + (c - 1) * CH + st) * 512 + h * 64 + 16 * rg + rl] = (t[0] + t[1]) + (t[2] + t[3]); }
        }
        asm volatile("s_waitcnt lgkmcnt(0)" ::: "memory"); __builtin_amdgcn_s_barrier(); asm volatile("" ::: "memory");
    }
    if (wid >= 6) { const int lt = tid - 384;
#pragma unroll
        for (int e = 0; e < 2; ++e) { const int oi = lt * 2 + e, st = oi >> 4, rl = oi & 15;
            const LAS f32x4* p4 = (const LAS f32x4*)(pb + ((NCH - 1) & 1) * 4096 + oi * 16);
            const f32x4 x0 = p4[0], x1 = p4[1], x2 = p4[2], x3 = p4[3];
            const f32x4 t = (x0 + x1) + (x2 + x3);
            OSC[((size_t)b * S + (NCH - 1) * CH + st) * 512 + h * 64 + 16 * rg + rl] = (t[0] + t[1]) + (t[2] + t[3]); } }
    __syncthreads();
#undef SCAN_ISSUE
}

#ifndef PHMASK
#define PHMASK 127
#endif
#ifndef DUPMASK
#define DUPMASK 0
#endif

struct Args { const float* in[23]; float* out; unsigned char* ws; int ph_lo, ph_hi; };

__global__ void __launch_bounds__(512) fwd(Args a) {
    extern __shared__ __attribute__((aligned(16))) unsigned char lds_raw[];
    LAS unsigned char* lds = (LAS unsigned char*)lds_raw;
    cg::grid_group grid = cg::this_grid();
    const int tid = threadIdx.x, lane = tid & 63, wave = __builtin_amdgcn_readfirstlane(tid >> 6);
    const int G = gridDim.x, bx = blockIdx.x, vc = vblock(bx, G);
    const int gw = bx * 8 + wave, ngw = G * 8;
    unsigned char* ws = a.ws;
    float* ctl = (float*)(ws + WS_CTL);
    float* rope = (float*)(ws + WS_ROPE);
    bf16_t* xb = (bf16_t*)(ws + WS_XB); bf16_t* P = (bf16_t*)(ws + WS_P); float* PRW = (float*)(ws + WS_PRW);
    bf16_t* Qf = (bf16_t*)(ws + WS_QF); bf16_t* Kf = (bf16_t*)(ws + WS_KF); bf16_t* Vf = (bf16_t*)(ws + WS_VF);
    float* SCN = (float*)(ws + WS_SCN); float* OSC = (float*)(ws + WS_OSC); bf16_t* ycat = (bf16_t*)(ws + WS_YCAT);
    float* M32 = (float*)(ws + WS_MRG32); bf16_t* Mb = (bf16_t*)(ws + WS_MRGB);
    const float* x_in = a.in[0];
    int ph = 0;
#define PH_ON() (ph >= a.ph_lo && ph < a.ph_hi)
    volatile LAS unsigned* xb_st = (volatile LAS unsigned*)(lds + LDS_BYTES - 16);
    if (tid < 4) xb_st[tid] = 0u;
    __syncthreads();
    XcdBarrier xbar = xcd_barrier_post((unsigned*)(ws + WS_CTL) + CTL_QUEUE + 32768, xb_st);
#define GBAR() xcd_barrier(xbar)
    if (a.ph_lo < 0) grid.sync();
#define SEAM() do { if (ph + 1 > a.ph_lo && ph + 1 < a.ph_hi) { GBAR(); } ++ph; } while (0)

    for (int rep = 0; rep < (((DUPMASK) & 1) ? 2 : 1); ++rep) { if (rep) GBAR(); if (PH_ON() && (PHMASK & 1)) {
        LAS float* scr = (LAS float*)(lds + wave * 8704);
        {
            constexpr int I_IN = 32 * 400, I_UQ = 8 * 64, I_UKV = 8 * 64, I_SB = 8 * 64, I_MLA = 16 * 64, I_RW = 8 * 64, I_OUT = 32 * 64;
            constexpr int I_LAYER = I_IN + I_UQ + I_UKV + I_SB + I_MLA + I_RW + I_OUT;
            for (int it = gw; it < 2 * I_LAYER; it += ngw) {
                const int l = it >= I_LAYER; int r = it - l * I_LAYER;
                bf16_t* wbr = (bf16_t*)(ws + WS_WBR) + (size_t)l * DM * DM;
                if (r < I_IN) { transpose_one(a.in[2] + (size_t)l * DM * 12480, 12480, NP, (bf16_t*)(ws + WS_WIN) + (size_t)l * NP * DM, DM, 0, a.in[1] + l * DM, 1, scr, r, lane); continue; } r -= I_IN;
                if (r < I_OUT) { transpose_one(a.in[22] + (size_t)l * DM * DM, DM, DM, (bf16_t*)(ws + WS_WOUT) + (size_t)l * DM * DM, DM, 0, nullptr, 0, scr, r, lane); continue; } r -= I_OUT;
                if (r < I_MLA) { transpose_one(a.in[20] + (size_t)l * 1024 * DM, DM, DM, wbr, DM, 512, nullptr, 0, scr, r, lane); continue; } r -= I_MLA;
                if (r < I_UQ) { transpose_one(a.in[5] + (size_t)l * 512 * 1536, 1536, 2048, (bf16_t*)(ws + WS_WUQ) + (size_t)l * 2048 * 512, 512, 0, a.in[3] + l * 512, 2, scr, r, lane); continue; } r -= I_UQ;
                if (r < I_UKV) { transpose_one(a.in[6] + (size_t)l * 512 * 2048, 2048, 2048, (bf16_t*)(ws + WS_WUKV) + (size_t)l * 2048 * 512, 512, 0, a.in[4] + l * 512, 0, scr, r, lane); continue; } r -= I_UKV;
                if (r < I_SB) { transpose_one(a.in[19] + (size_t)l * 512 * DM, DM, DM, wbr, DM, 0, nullptr, 0, scr, r, lane); continue; } r -= I_SB;
                transpose_one(a.in[21] + (size_t)l * 512 * DM, DM, DM, wbr, DM, 1536, nullptr, 0, scr, r, lane);
            }
        }
        for (int m = gw; m < T; m += ngw) {
            const f32x4* xr = (const f32x4*)(x_in + (size_t)m * DM) + lane; float sq = 0.f;
            u32x2* o8 = (u32x2*)(xb + (size_t)m * DM) + lane;
#pragma unroll
            for (int j = 0; j < 8; ++j) { const f32x4 v = __builtin_nontemporal_load(xr + 64 * j); sq += (v[0] * v[0] + v[1] * v[1]) + (v[2] * v[2] + v[3] * v[3]);
                u32x2 w; w.x = pk2(v[0], v[1]); w.y = pk2(v[2], v[3]); o8[64 * j] = w; }
            sq = wave_sum(sq);
            if (lane == 0) ctl[CTL_SSQX + m] = sq;
        }
        for (int e = bx * 512 + tid; e < S * 32; e += G * 512) {
            const int pos = e >> 5, i = e & 31;
            double f = 1.0; for (int k = 0; k < i; ++k) f *= 0.7498942093324559;
            const float ff = (float)f, ang = (float)pos * ff;
            float sn, cs; sincos_acc(ang, sn, cs);
            rope[e] = cs; rope[S * 32 + e] = sn;
        }
    } }
    SEAM();

    for (int l = 0; l < 2; ++l) {
        float* ssqx = ctl + CTL_SSQX + l * T; float* ssq_cq = ctl + CTL_SSQCQ + l * T; float* ssq_ckv = ctl + CTL_SSQCKV + l * T; float* ssq_kr = ctl + CTL_SSQKR + l * T;
        if (PH_ON()) {
            SchedA1 Sd{(const char*)xb, (const char*)((bf16_t*)(ws + WS_WIN) + (size_t)l * NP * DM), G, vc, (G == 256) ? 32 : 0};
            EpiA E{P, PRW, ssqx, ssq_cq, ssq_ckv, ssq_kr};
            pg8::gemm_phase(lds, DM, DM, Sd, E);
        }
        SEAM();
        if (PH_ON()) {
            RwParams rp{PRW, a.in[9] + l * 1664, a.in[10] + l * 512, a.in[11] + (size_t)l * 64 * 512, a.in[12] + l * 512, a.in[13] + (size_t)l * 64 * 512,
                        a.in[14] + l * 512, a.in[15] + l * 512, SCN};
            for (int tile = bx; tile < 256; tile += G) rw_prep_mfma(lds, rp, tile);
        }
        SEAM();
        for (int rep = 0; rep < 1; ++rep) { if (PH_ON()) {
            const int nscan = (G == 256) ? 64 : 0;
            constexpr int A2_MAIN = 43 * 32 - 32;
            unsigned* sbar = (unsigned*)(ws + WS_CTL) + CTL_QUEUE + 2048;
            const unsigned nsub = (unsigned)(G - nscan);
            if (bx < nscan) {
                rw_scan(lds, SCN, OSC, ((bx & 15) << 2) | (bx >> 4));
                {
                    const int bh = bx & 15, rgq = bx >> 4, hb = bh >> 3, hh = bh & 7;
                    grid_bar((unsigned*)(ws + WS_CTL) + CTL_QUEUE + 4096 + 64 * bh, 4u * (unsigned)(l + 1));
                    if (tid == 0) { while (__hip_atomic_load(sbar, __ATOMIC_RELAXED, __HIP_MEMORY_SCOPE_AGENT) < nsub * (unsigned)(2 * l + 1)) __builtin_amdgcn_s_sleep(8);
                                    __builtin_amdgcn_fence(__ATOMIC_ACQUIRE, "agent"); asm volatile("s_waitcnt vmcnt(0)" ::: "memory"); }
                    __syncthreads();
                    {
                        int tl = threadIdx.x; asm volatile("" : "+v"(tl)); const int ln = tl & 63, ch = hh * 64 + ln;
                        const float gng_c = a.in[17][l * 512 + ch], gnb_c = a.in[18][l * 512 + ch], rk_c = a.in[16][l * 512 + ch];
                        const size_t tq0 = (size_t)hb * S + 1024 * rgq;
                        const float* osc_b = OSC + tq0 * 512 + ch; const float* scn_b = SCN + ((size_t)bh * S + 1024 * rgq) * 384 + ln;
                        const bf16_t* g_b = P + tq0 * NP + PC_RG + ch; bf16_t* y_b = ycat + tq0 * DM + 1536 + ch;
                        float ov0[8], rr0[8], kk0[8], vv0[8], gg0[8], ov1[8], rr1[8], kk1[8], vv1[8], gg1[8];
#define FIN_LOAD(OV, RR, KK, VV, GG, tok) do { _Pragma("unroll") for (int q = 0; q < 8; ++q) { const size_t t_ = (size_t)((tok) + q); \
        OV[q] = osc_b[t_ * 512]; RR[q] = scn_b[t_ * 384]; KK[q] = scn_b[t_ * 384 + 128]; VV[q] = scn_b[t_ * 384 + 320]; GG[q] = bf2f(g_b[t_ * NP]); } } while (0)
#define FIN_COMP(OV, RR, KK, VV, GG, tok) do { _Pragma("unroll") for (int q = 0; q < 8; ++q) { \
        const float mu = wsum64(OV[q]) * (1.f / 64.f), d = OV[q] - mu, var = wsum64(d * d) * (1.f / 64.f); \
        const float y = d * __builtin_amdgcn_rsqf(var + 64e-5f) * gng_c + gnb_c; \
        const float bonus = wsum64(RR[q] * KK[q] * rk_c) * VV[q]; \
        y_b[(size_t)((tok) + q) * DM] = (bf16_t)(cvtpk((y + bonus) * GG[q], 0.f) & 0xffffu); } } while (0)
                        FIN_LOAD(ov0, rr0, kk0, vv0, gg0, wave * 8);
                        for (int i8 = wave * 8; i8 < 1024; i8 += 128) {
                            FIN_LOAD(ov1, rr1, kk1, vv1, gg1, i8 + 64);
                            FIN_COMP(ov0, rr0, kk0, vv0, gg0, i8);
                            if (i8 + 128 < 1024) FIN_LOAD(ov0, rr0, kk0, vv0, gg0, i8 + 128);
                            FIN_COMP(ov1, rr1, kk1, vv1, gg1, i8 + 64);
                        }
#undef FIN_LOAD
#undef FIN_COMP
                    }
                }
                if (tid == 0) { while (__hip_atomic_load(sbar, __ATOMIC_RELAXED, __HIP_MEMORY_SCOPE_AGENT) < nsub * (unsigned)(2 * l + 2)) __builtin_amdgcn_s_sleep(8);
                                __builtin_amdgcn_fence(__ATOMIC_ACQUIRE, "agent"); asm volatile("s_waitcnt vmcnt(0)" ::: "memory"); }
                __syncthreads();
            } else {
                if (nscan == 0) { for (int sb = bx; sb < 64; sb += G) rw_scan(lds, SCN, OSC, sb); }
                {   SchedA2 Sd{(const char*)xb, (const char*)((bf16_t*)(ws + WS_WIN) + (size_t)l * NP * DM), bx - nscan, G - nscan, nscan ? A2_MAIN : 43 * 32};
                    EpiA E{P, PRW, ssqx, ssq_cq, ssq_ckv, ssq_kr};
                    pg8::gemm_phase(lds, DM, DM, Sd, E); }
                grid_bar(sbar, nsub * (unsigned)(2 * l + 1));
                {   SchedB Sd{(const char*)P, (const char*)((bf16_t*)(ws + WS_WUQ) + (size_t)l * 2048 * 512), (const char*)((bf16_t*)(ws + WS_WUKV) + (size_t)l * 2048 * 512), G - nscan, vblock(bx - nscan, G - nscan)};
                    EpiB E{Qf, Kf, Vf, P, ssq_cq, ssq_ckv, ssq_kr, a.in[7] + l * 192, a.in[8] + l * 192, rope, (LAS float*)(lds + LDS_SCR)};
                    pg8::gemm_phase(lds, NP, 512, Sd, E); }
                grid_bar(sbar, nsub * (unsigned)(2 * l + 2));
            }
            unsigned* queue = (unsigned*)(ws + WS_CTL) + CTL_QUEUE + l * 64 + rep * 32;
            LAS unsigned* ubox = (LAS unsigned*)(lds + LDS_SCR + 8192);
            for (;;) {
#if defined(DUPC_SCANONLY)
                if (rep) break;
#endif
                if (tid == 0) *ubox = atomicAdd(queue, 1u);
                __syncthreads();
                const unsigned u = *ubox;
                __syncthreads();
                if (u >= 384u) break;
                if (u < 256u) {
                    const int qb = 15 - (int)(u >> 4), bh = u & 15, b = bh >> 3, h = bh & 7;
                    const size_t t0 = (size_t)b * S + qb * 256, tb = (size_t)b * S;
#ifndef NO_MLA
                    attn_unit<192, false>(lds, Qf + t0 * 1536 + h * 192, 1536, Kf + tb * 1536 + h * 192, 1536, Vf + tb * 1024 + h * 128, 1024,
                                          P + t0 * NP + PC_MG + h * 128, NP, ycat + t0 * DM + 512 + h * 128, DM, qb);
#endif
                } else {
                    const unsigned u2 = u - 256u; const int qb = 15 - (int)(u2 >> 3), bh = u2 & 7, b = bh >> 2, h = bh & 3;
                    const size_t t0 = (size_t)b * S + qb * 256, tb = (size_t)b * S;
#ifndef NO_SB
                    attn_unit<128, true>(lds, P + t0 * NP + PC_SBQ + h * 128, NP, P + tb * NP + PC_SBK + h * 128, NP, P + tb * NP + PC_SBV + h * 128, NP,
                                         P + t0 * NP + PC_SBG + h * 128, NP, ycat + t0 * DM + h * 128, DM, qb);
#endif
                }
            }
        } }
        SEAM();
        if (PH_ON()) {
            if (G != 256) { for (int it0 = gw * 4; it0 < T * 8; it0 += ngw * 4) rw_finaliseN<4>(it0, 1, a.in[17] + l * 512, a.in[18] + l * 512, a.in[16] + l * 512, OSC, SCN, P, ycat); }
        }
        if (G != 256) { SEAM(); } else { ++ph; }
        for (int rep = 0; rep < (((DUPMASK) & 32) ? 2 : 1); ++rep) { if (rep) GBAR(); if (PH_ON() && (PHMASK & 32)) {
            SchedD Sd{(const char*)ycat, (const char*)((bf16_t*)(ws + WS_WBR) + (size_t)l * DM * DM), G, vc};
            EpiD E{Mb, P};
            pg8::gemm_phase(lds, DM, DM, Sd, E);
        } }
        SEAM();
        for (int rep = 0; rep < (((DUPMASK) & 64) ? 2 : 1); ++rep) { if (rep) GBAR(); if (PH_ON() && (PHMASK & 64)) {
            SchedE Sd{(const char*)Mb, (const char*)((bf16_t*)(ws + WS_WOUT) + (size_t)l * DM * DM), G, vc};
            if (rep && l == 1) break;
            EpiE E{l == 0 ? x_in : a.out, a.out, xb, l == 0 ? (ctl + CTL_SSQX + T) : nullptr, rep != 0};
            pg8::gemm_phase(lds, DM, DM, Sd, E);
        } }
        SEAM();
    }
}

#ifndef MK_MULTI
#define MK_MULTI 0
#endif
extern "C" void kernel_launch(void* const* d_in, const int* in_sizes, int n_in, void* d_out, int out_size, void* d_ws, size_t ws_size, hipStream_t stream) {
    static int grid = 0;
    if (grid == 0) {
        if (n_in != 23 || out_size != T * DM || ws_size < WS_END) { fprintf(stderr, "kernel_launch: unexpected shapes (n_in %d out %d ws %zu)\n", n_in, out_size, ws_size); grid = -1; return; }
        int dev = 0, cus = 0, per_cu = 0;
        (void)hipGetDevice(&dev);
        (void)hipDeviceGetAttribute(&cus, hipDeviceAttributeMultiprocessorCount, dev);
        (void)hipFuncSetAttribute((const void*)fwd, hipFuncAttributeMaxDynamicSharedMemorySize, LDS_BYTES);
        (void)hipOccupancyMaxActiveBlocksPerMultiprocessor(&per_cu, (const void*)fwd, 512, LDS_BYTES);
        if (per_cu < 1) per_cu = 1;
        grid = cus * per_cu;
    }
    if (grid < 0) return;
    (void)hipMemsetAsync((char*)d_ws + WS_CTL, 0, 1 * MiB, stream);
    Args a{};
    for (int i = 0; i < 23; ++i) a.in[i] = (const float*)d_in[i];
    a.out = (float*)d_out; a.ws = (unsigned char*)d_ws;
#if MK_MULTI
    for (int p = 0; p < 13; ++p) { a.ph_lo = p; a.ph_hi = p + 1; hipLaunchKernelGGL(fwd, dim3(grid), dim3(512), LDS_BYTES, stream, a); }
#else
    a.ph_lo = 0; a.ph_hi = 13;
    void* args[] = {&a};
    hipError_t e = hipLaunchCooperativeKernel((const void*)fwd, dim3(grid), dim3(512), args, LDS_BYTES, stream);
    if (e != hipSuccess) fprintf(stderr, "cooperative launch failed: %s (grid %d)\n", hipGetErrorString(e), grid);
#endif
}
```

```cpp
#include <hip/hip_runtime.h>
#include <hip/hip_cooperative_groups.h>
#include <cstdio>
#include <cstdint>
namespace cg = cooperative_groups;

#define LAS __attribute__((address_space(3)))
typedef unsigned short bf16_t;
typedef short bf16x8 __attribute__((ext_vector_type(8)));
typedef short s16x4 __attribute__((ext_vector_type(4)));
typedef float f32x2 __attribute__((ext_vector_type(2)));
typedef float f32x4 __attribute__((ext_vector_type(4)));
typedef float f32x16 __attribute__((ext_vector_type(16)));
typedef unsigned u32x4 __attribute__((ext_vector_type(4)));
typedef unsigned u32x2 __attribute__((ext_vector_type(2)));

constexpr int T = 8192, S = 4096, DM = 2048, NP = 12800;
constexpr int PRW_LD = 1792;
constexpr int PC_SBQ = 0, PC_SBK = 512, PC_SBV = 1024, PC_SBG = 1536, PC_CQ = 2048, PC_CKV = 2560, PC_KR = 3072, PC_MG = 3328,
              PC_RG = 6144, PC_GATE = 6656;
constexpr float EPS = 1e-6f;
constexpr float CQ_MLA = 0.10411754627697264f;
constexpr float SCALE_SB = 0.08838834764831845f;

constexpr size_t MiB = 1u << 20;
constexpr size_t WS_CTL = 0, WS_ROPE = 1 * MiB, WS_WIN = 2 * MiB, WS_WUQ = 102 * MiB, WS_WUKV = 106 * MiB, WS_WBR = 110 * MiB, WS_WOUT = 126 * MiB,
                 WS_XB = 142 * MiB, WS_P = 174 * MiB, WS_PRW = 374 * MiB, WS_QF = 430 * MiB, WS_KF = 454 * MiB, WS_VF = 478 * MiB, WS_SCN = 494 * MiB,
                 WS_OSC = 590 * MiB, WS_YCAT = 606 * MiB, WS_MRG32 = 638 * MiB, WS_MRGB = 702 * MiB, WS_END = 734 * MiB;
constexpr int CTL_SSQX = 0, CTL_SSQCQ = 2 * T, CTL_SSQCKV = 4 * T, CTL_SSQKR = 6 * T, CTL_QUEUE = 131072;

constexpr int LDS_RING = 131072, LDS_SCR = 131072, LDS_BYTES = 147456;

__device__ __forceinline__ unsigned f2bf(float f) { unsigned u = __builtin_bit_cast(unsigned, f); return (u + 0x7fffu + ((u >> 16) & 1u)) >> 16; }
__device__ __forceinline__ unsigned pk2(float lo, float hi) { return f2bf(lo) | (f2bf(hi) << 16); }
__device__ __forceinline__ unsigned cvtpk(float lo, float hi) { unsigned r; asm volatile("v_cvt_pk_bf16_f32 %0, %1, %2" : "=v"(r) : "v"(lo), "v"(hi)); return r; }
__device__ __forceinline__ float bf2f(unsigned short b) { return __builtin_bit_cast(float, (unsigned)b << 16); }
__device__ __forceinline__ float bflo(unsigned w) { return __builtin_bit_cast(float, w << 16); }
__device__ __forceinline__ float bfhi(unsigned w) { return __builtin_bit_cast(float, w & 0xffff0000u); }
__device__ __forceinline__ float wave_sum(float v) {
#pragma unroll
    for (int o = 1; o < 64; o <<= 1) v += __shfl_xor(v, o);
    return v;
}
__device__ __forceinline__ float fsigmoid(float x) { return __builtin_amdgcn_rcpf(1.f + __expf(-x)); }
__device__ __forceinline__ float fsilu(float x) { return x * fsigmoid(x); }
#define LDS_WAIT() asm volatile("s_waitcnt lgkmcnt(0)" ::: "memory")

namespace pg8 {
constexpr int BM = 256, BK = 64, HALF = 128, HTB = HALF * BK * 2;
__device__ __forceinline__ int lds_byte(int r, int c) { const int st = (r >> 4) * 2 + (c >> 5), rr = r & 15, cc = c & 31, ob = rr * 64 + cc * 2; return st * 1024 + (ob ^ (((ob >> 9) & 1) << 5)); }
__device__ __forceinline__ void stage_rc(int b, int& R, int& C) { const int st = b / 1024, sb = b % 1024, swz = sb ^ (((sb >> 9) & 1) << 5); R = (st >> 1) * 16 + swz / 64; C = (st & 1) * 32 + (swz % 64) / 2; }
__device__ __forceinline__ int perm32(int rho) { const int n = rho >> 4, i = rho & 15; return 8 * (i >> 2) + 4 * n + (i & 3); }

struct GUnit { const char* A; const char* B; int nt, pm, pn, aux; };

template <class Epi, class Sched>
__device__ __forceinline__ void gemm_phase(LAS unsigned char* lds, const int lda, const int ldb, const Sched& S, const Epi& E) {
    int tid = threadIdx.x; asm volatile("" : "+v"(tid));
    const int wid = __builtin_amdgcn_readfirstlane(tid >> 6), lane = tid & 63, wr = wid >> 2, wc = wid & 3, fr = lane & 15, fq = lane >> 4;
    unsigned voffA[2], voffB[2];
#pragma unroll
    for (int i = 0; i < 2; ++i) { int R, C; stage_rc(tid * 16 + i * 8192, R, C); const int Rb = (R & ~31) + perm32(R & 31);
        voffA[i] = (unsigned)(R * lda + C) * 2u; voffB[i] = (unsigned)(Rb * ldb + C) * 2u; }
    const size_t kstep = (size_t)(BK * 2);
    const size_t hstepA = (size_t)HALF * lda * 2, hstepB = (size_t)HALF * ldb * 2;
    const unsigned ldsw = (unsigned)wid * 1024u;
    const int aoff = lds_byte(wr * 64 + fr, fq * 8), boff = lds_byte(wc * 32 + fr, fq * 8);
#define PG8_SA(b, h) (((b) * 2 + (h)) * HTB)
#define PG8_SB(b, h) ((4 + (b) * 2 + (h)) * HTB)
#define PG8_STAGE(bufoff, gbase, voff) do { _Pragma("unroll") for (int _i = 0; _i < 2; ++_i) \
        __builtin_amdgcn_global_load_lds((const unsigned*)((const char*)(gbase) + (voff)[_i]), (LAS unsigned*)(lds + (bufoff) + ldsw + _i * 8192), 16, 0, 0); } while (0)
#define PG8_LDA(dst, b, h) do { _Pragma("unroll") for (int m = 0; m < 4; ++m) _Pragma("unroll") for (int k = 0; k < 2; ++k) dst[m][k] = *(const LAS bf16x8*)(lds + PG8_SA(b, h) + aoff + m * 2048 + k * 1024); } while (0)
#define PG8_LDB(dst, b, h) do { _Pragma("unroll") for (int n = 0; n < 2; ++n) _Pragma("unroll") for (int k = 0; k < 2; ++k) dst[n][k] = *(const LAS bf16x8*)(lds + PG8_SB(b, h) + boff + n * 2048 + k * 1024); } while (0)
#define PG8_MMA(ai, bj, At, Bt) do { __builtin_amdgcn_s_setprio(1); _Pragma("unroll") for (int m = 0; m < 4; ++m) _Pragma("unroll") for (int n = 0; n < 2; ++n) _Pragma("unroll") for (int k = 0; k < 2; ++k) \
        acc[ai][bj][m][n] = __builtin_amdgcn_mfma_f32_16x16x32_bf16(Bt[n][k], At[m][k], acc[ai][bj][m][n], 0, 0, 0); __builtin_amdgcn_s_setprio(0); } while (0)
#define PG8_WAIT_V(n) asm volatile("s_waitcnt vmcnt(" #n ")" ::: "memory")
#define PG8_WAIT_L(n) asm volatile("s_waitcnt lgkmcnt(" #n ")" ::: "memory")
#define PG8_BAR __builtin_amdgcn_s_barrier()
#define PG8_SCHED __builtin_amdgcn_sched_barrier(0)
    GUnit cur, nxt; int ui = 0;
    if (!S.next(0, cur)) return;
    f32x4 acc[2][2][4][2];
#pragma unroll
    for (int a = 0; a < 2; ++a)
#pragma unroll
        for (int b = 0; b < 2; ++b)
#pragma unroll
            for (int m = 0; m < 4; ++m)
#pragma unroll
                for (int n = 0; n < 2; ++n) acc[a][b][m][n] = (f32x4){0.f, 0.f, 0.f, 0.f};
    bf16x8 At[4][2], B0[2][2], B1[2][2];
    const char* cA = cur.A; const char* cB = cur.B;
    PG8_STAGE(PG8_SB(0, 0), cB, voffB); PG8_STAGE(PG8_SB(0, 1), cB + hstepB, voffB); PG8_STAGE(PG8_SA(0, 0), cA, voffA); PG8_STAGE(PG8_SA(0, 1), cA + hstepA, voffA);
    if (wr == 1) PG8_BAR;
    PG8_WAIT_V(2); PG8_BAR;
    PG8_STAGE(PG8_SB(1, 0), cB + kstep, voffB); PG8_STAGE(PG8_SA(1, 0), cA + kstep, voffA); PG8_STAGE(PG8_SB(1, 1), cB + hstepB + kstep, voffB);
    PG8_WAIT_V(6); PG8_BAR;
    for (;;) {
        const bool has_next = S.next(ui + 1, nxt);
        const char* nA = has_next ? nxt.A : cA; const char* nB = has_next ? nxt.B : cB;
        const int nt = cur.nt;
        for (int t = 0; t < nt; t += 2) {
            if constexpr (Epi::HAS_MID) { if (t == 8 || t == 24) { int fr_ = fr, fq_ = fq; asm volatile("" : "+v"(fr_), "+v"(fq_)); E.mid(acc, cur, t, wr, wc, fr_, fq_); } }
            const bool last = (t == nt - 2);
            const char* a1 = cA + (size_t)(t + 1) * kstep;
            const char* a2 = last ? nA : cA + (size_t)(t + 2) * kstep; const char* b2 = last ? nB : cB + (size_t)(t + 2) * kstep;
            const char* a3 = a2 + kstep; const char* b3 = b2 + kstep;
            PG8_LDB(B0, 0, 0); PG8_LDB(B1, 0, 1); PG8_SCHED; PG8_LDA(At, 0, 0); PG8_STAGE(PG8_SA(1, 1), a1 + hstepA, voffA);
            PG8_WAIT_V(8); PG8_WAIT_L(0); PG8_BAR; PG8_MMA(0, 0, At, B0); PG8_MMA(0, 1, At, B1); PG8_BAR; PG8_SCHED;
            PG8_LDA(At, 0, 1); PG8_STAGE(PG8_SB(0, 0), b2, voffB); PG8_STAGE(PG8_SB(0, 1), b2 + hstepB, voffB); PG8_STAGE(PG8_SA(0, 0), a2, voffA);
            PG8_WAIT_V(8); PG8_WAIT_L(0); PG8_BAR; PG8_MMA(1, 0, At, B0); PG8_MMA(1, 1, At, B1); PG8_BAR; PG8_SCHED;
            PG8_LDB(B0, 1, 0); PG8_LDB(B1, 1, 1); PG8_SCHED; PG8_LDA(At, 1, 0); PG8_STAGE(PG8_SA(0, 1), a2 + hstepA, voffA);
            PG8_WAIT_V(8); PG8_WAIT_L(0); PG8_BAR; PG8_MMA(0, 0, At, B0); PG8_MMA(0, 1, At, B1); PG8_BAR; PG8_SCHED;
            PG8_LDA(At, 1, 1); PG8_STAGE(PG8_SB(1, 0), b3, voffB); PG8_STAGE(PG8_SB(1, 1), b3 + hstepB, voffB); PG8_STAGE(PG8_SA(1, 0), a3, voffA);
            PG8_WAIT_V(8); PG8_WAIT_L(0); PG8_BAR; PG8_MMA(1, 0, At, B0); PG8_MMA(1, 1, At, B1); PG8_BAR; PG8_SCHED;
        }
        if (wr == 0) PG8_BAR;
        { GUnit eu = cur; eu.pm = __builtin_amdgcn_readfirstlane(cur.pm); eu.pn = __builtin_amdgcn_readfirstlane(cur.pn); eu.aux = __builtin_amdgcn_readfirstlane(cur.aux);
          int wr_ = wr, wc_ = wc, fr_ = fr, fq_ = fq;
          asm volatile("" : "+s"(eu.pm), "+s"(eu.pn), "+s"(eu.aux), "+s"(wr_), "+s"(wc_), "+v"(fr_), "+v"(fq_));
          E(acc, eu, wr_, wc_, fr_, fq_); }
        if (!has_next) break;
#pragma unroll
        for (int a = 0; a < 2; ++a)
#pragma unroll
            for (int b = 0; b < 2; ++b)
#pragma unroll
                for (int m = 0; m < 4; ++m)
#pragma unroll
                    for (int n = 0; n < 2; ++n) acc[a][b][m][n] = (f32x4){0.f, 0.f, 0.f, 0.f};
        cur = nxt; cA = nA; cB = nB; ++ui;
        if (wr == 1) PG8_BAR;
    }
    PG8_WAIT_V(0);
    PG8_BAR;
#undef PG8_SA
#undef PG8_SB
#undef PG8_STAGE
#undef PG8_LDA
#undef PG8_LDB
#undef PG8_MMA
#undef PG8_WAIT_V
#undef PG8_WAIT_L
#undef PG8_SCHED
}
}
using pg8::GUnit;

#define XB_TMO      128
#define XB_XCNT(j)  (256  + 64 * (j))
#define XB_XSUB(j)  (1280 + 64 * (j))
#define XB_XGEN(j)  (2304 + 64 * (j))
#define XB_TOP      3328
#define XB_TOPGEN   3392
#define XCD_BAR_WORDS 3456
#define XB_SPIN_CAP (1u << 18)

__device__ __forceinline__ unsigned xb_ld(unsigned* p)              { return __hip_atomic_load(p, __ATOMIC_RELAXED, __HIP_MEMORY_SCOPE_AGENT); }
__device__ __forceinline__ unsigned xb_add(unsigned* p, unsigned v) { return __hip_atomic_fetch_add(p, v, __ATOMIC_RELAXED, __HIP_MEMORY_SCOPE_AGENT); }
__device__ __forceinline__ unsigned xb_xcc_id() { return (unsigned)__builtin_amdgcn_s_getreg((3 << 11) | 20) & 0xFu; }
#define XB_SPIN(cond, bar) do { unsigned _sp = 0; while (cond) { __builtin_amdgcn_s_sleep(1); \
    if ((++_sp & 255u) == 0u) { if (xb_ld(&(bar)[XB_TMO])) break; if (_sp > XB_SPIN_CAP) { atomicAdd(&(bar)[XB_TMO], 1u); break; } } } } while (0)

struct XcdBarrier {
    unsigned* bar; unsigned x;
    volatile LAS unsigned* st;
};

__device__ __forceinline__ XcdBarrier xcd_barrier_post(unsigned* bar, volatile LAS unsigned* st) {
    XcdBarrier b; b.bar = bar; b.x = xb_xcc_id(); b.st = st;
    if (threadIdx.x == 0) (void)xb_add(&bar[XB_XCNT(b.x)], 1u);
    return b;
}
__device__ __forceinline__ void xcd_barrier_complete(unsigned* bar, unsigned x, unsigned& nloc, unsigned& nx) {
    const unsigned G = gridDim.x * gridDim.y * gridDim.z;
    unsigned sum, cnt, mine, sp = 0u;
    for (;;) {
        sum = 0u; cnt = 0u; mine = 0u;
#pragma unroll
        for (unsigned j = 0; j < 16; ++j) { const unsigned c = xb_ld(&bar[XB_XCNT(j)]); sum += c; cnt += (c > 0u) ? 1u : 0u; mine = (j == x) ? c : mine; }
        if (sum == G) break;
        __builtin_amdgcn_s_sleep(1);
        if ((++sp & 255u) == 0u) { if (xb_ld(&bar[XB_TMO])) break; if (sp > XB_SPIN_CAP) { atomicAdd(&bar[XB_TMO], 1u); break; } }
    }
    nloc = mine > 0u ? mine : 1u; nx = cnt > 0u ? cnt : 1u;
}

__device__ __forceinline__ void xcd_barrier(const XcdBarrier& b) {
    asm volatile("s_waitcnt vmcnt(0)" ::: "memory");
    __syncthreads();
    if (threadIdx.x == 0) {
        unsigned* bar = b.bar;
        __builtin_amdgcn_s_waitcnt(0);
        unsigned nloc = b.st[0], nx = b.st[1];
        if (nloc == 0u) { xcd_barrier_complete(bar, b.x, nloc, nx); b.st[0] = nloc; b.st[1] = nx; }
        const unsigned old = xb_add(&bar[XB_XSUB(b.x)], 1u);
        const unsigned gen = old / nloc;
        if (old + 1u == (gen + 1u) * nloc) {
            __builtin_amdgcn_fence(__ATOMIC_RELEASE, "agent");
            asm volatile("s_waitcnt vmcnt(0)" ::: "memory");
            const unsigned og = xb_add(&bar[XB_TOP], 1u);
            const unsigned tg = og / nx;
            if (og + 1u == (tg + 1u) * nx) xb_add(&bar[XB_TOPGEN], 1u);
            else XB_SPIN(xb_ld(&bar[XB_TOPGEN]) == tg, bar);
            __builtin_amdgcn_fence(__ATOMIC_ACQUIRE, "agent");
            xb_add(&bar[XB_XGEN(b.x)], 1u);
            asm volatile("s_waitcnt vmcnt(0)" ::: "memory");
        } else {
            XB_SPIN(xb_ld(&bar[XB_XGEN(b.x)]) == gen, bar);
            __builtin_amdgcn_fence(__ATOMIC_ACQUIRE, "agent");
            asm volatile("s_waitcnt vmcnt(0)" ::: "memory");
        }
    }
    __syncthreads();
}


__device__ __forceinline__ void grid_bar(unsigned* cnt, unsigned target) {
    asm volatile("s_waitcnt vmcnt(0) lgkmcnt(0)" ::: "memory");
    __syncthreads();
    if (threadIdx.x == 0) {
        __builtin_amdgcn_fence(__ATOMIC_RELEASE, "agent");
        asm volatile("s_waitcnt vmcnt(0)" ::: "memory");
        __hip_atomic_fetch_add(cnt, 1u, __ATOMIC_RELAXED, __HIP_MEMORY_SCOPE_AGENT);
        while (__hip_atomic_load(cnt, __ATOMIC_RELAXED, __HIP_MEMORY_SCOPE_AGENT) < target) __builtin_amdgcn_s_sleep(1);
        __builtin_amdgcn_fence(__ATOMIC_ACQUIRE, "agent");
        asm volatile("s_waitcnt vmcnt(0)" ::: "memory");
    }
    __syncthreads();
}

__device__ __forceinline__ int vblock(int c, int G) { return (G % 8 == 0) ? (c % 8) * (G / 8) + c / 8 : c; }

struct SchedA {
    const char* A; const char* B; int G, c;
    __device__ __forceinline__ bool next(int i, GUnit& u) const {
        constexpr int nM = 32, nN = 50, nwg = nM * nN, NXCD = 8, WGM = 8;
        const long L = (long)i * G + c; if (L >= nwg) return false;
        int wgid = (int)L; { const int q = nwg / NXCD, r = nwg % NXCD, xcd = wgid % NXCD, off = wgid / NXCD; wgid = (xcd < r ? xcd * (q + 1) : r * (q + 1) + (xcd - r) * q) + off; }
        const int nig = WGM * nN, gid = wgid / nig, fm = gid * WGM, gsz = (nM - fm) < WGM ? (nM - fm) : WGM;
        u.pm = fm + ((wgid % nig) % gsz); u.pn = (wgid % nig) / gsz; u.nt = 32; u.aux = 0;
        u.A = A + (size_t)u.pm * 256 * DM * 2; u.B = B + (size_t)u.pn * 256 * DM * 2; return true;
    }
};
struct SchedA2 {
    const char* A; const char* B; int first, stride, limit;
    __device__ __forceinline__ bool next(int i, GUnit& u) const {
        constexpr int nM = 32, nN = 43, nwg = nM * nN, NXCD = 8, WGM = 8;
        const int L = first + i * stride; if (L >= limit) return false;
        int wgid = L; { const int q = nwg / NXCD, r = nwg % NXCD, xcd = wgid % NXCD, off = wgid / NXCD; wgid = (xcd < r ? xcd * (q + 1) : r * (q + 1) + (xcd - r) * q) + off; }
        const int nig = WGM * nN, gid = wgid / nig, fm = gid * WGM, gsz = (nM - fm) < WGM ? (nM - fm) : WGM;
        u.pm = fm + ((wgid % nig) % gsz); const int pn = (wgid % nig) / gsz; u.pn = pn < 17 ? pn : pn + 7; u.nt = 32; u.aux = 0;
        u.A = A + (size_t)u.pm * 256 * DM * 2; u.B = B + (size_t)u.pn * 256 * DM * 2; return true;
    }
};
struct SchedA1 {
    const char* A; const char* B; int G, vc, extra;
    __device__ __forceinline__ bool next(int i, GUnit& u) const {
        const int L = i * G + vc; if (L >= 224 + extra) return false;
        if (L >= 224) { SchedA2 s2{A, B, 43 * 32 - 32 + (L - 224), 1 << 20, 43 * 32}; return s2.next(0, u); }
        u.pm = L / 7; u.pn = 17 + L % 7; u.nt = 32; u.aux = 0;
        u.A = A + (size_t)u.pm * 256 * DM * 2; u.B = B + (size_t)u.pn * 256 * DM * 2; return true;
    }
};
struct SchedB {
    const char* P; const char* Wq; const char* Wkv; int G, vc;
    __device__ __forceinline__ bool next(int i, GUnit& u) const {
        const int L = i * G + vc; if (L >= 512) return false;
        const int isq = (L < 256), l2 = L & 255; u.pm = l2 >> 3; u.pn = l2 & 7; u.nt = 8; u.aux = isq ? 0 : 1;
        u.A = P + ((size_t)u.pm * 256 * NP + (isq ? PC_CQ : PC_CKV)) * 2; u.B = (isq ? Wq : Wkv) + (size_t)u.pn * 256 * 512 * 2; return true;
    }
};
struct SchedD {
    const char* Y; const char* W; int G, vc;
    __device__ __forceinline__ bool next(int i, GUnit& u) const {
        const int tile = i * G + vc; if (tile >= 256) return false;
        u.pm = tile >> 3; u.pn = tile & 7; u.aux = 0; u.nt = 32;
        u.A = Y + (size_t)u.pm * 256 * DM * 2; u.B = W + (size_t)u.pn * 256 * DM * 2; return true;
    }
};
struct SchedE {
    const char* A; const char* B; int G, vc;
    __device__ __forceinline__ bool next(int i, GUnit& u) const {
        const int tile = i * G + vc; if (tile >= 256) return false;
        u.pm = tile >> 3; u.pn = tile & 7; u.aux = 0; u.nt = 32;
        u.A = A + (size_t)u.pm * 256 * DM * 2; u.B = B + (size_t)u.pn * 256 * DM * 2; return true;
    }
};

struct EpiA {
    static constexpr bool HAS_MID = false;
    bf16_t* P; float* PRW; const float* ssqx; float* ssq_cq; float* ssq_ckv; float* ssq_kr;
    __device__ __forceinline__ void operator()(const f32x4 (&acc)[2][2][4][2], const GUnit& u, int wr, int wc, int fr, int fq) const {
        const int pn = u.pn;
        const int kind = (pn < 6) ? 0 : (pn < 8) ? 1 : (pn < 13) ? 0 : (pn < 17) ? 1 : (pn < 24) ? 3 : (pn < 26) ? 1 : 2;
        float* ssq = (pn >= 8 && pn < 10) ? ssq_cq : (pn >= 10 && pn < 12) ? ssq_ckv : (pn == 12) ? ssq_kr : nullptr;
        const int row0 = u.pm * 256 + wr * 64 + fr;
        float rsv[2][4];
#pragma unroll
        for (int ai = 0; ai < 2; ++ai)
#pragma unroll
            for (int m = 0; m < 4; ++m) rsv[ai][m] = ssqx[row0 + ai * 128 + m * 16];
#pragma unroll
        for (int ai = 0; ai < 2; ++ai)
#pragma unroll
            for (int m = 0; m < 4; ++m) rsv[ai][m] = rsqrtf(rsv[ai][m] * (1.f / 2048.f) + EPS);
#pragma unroll
        for (int ai = 0; ai < 2; ++ai)
#pragma unroll
            for (int m = 0; m < 4; ++m) {
                const int row = row0 + ai * 128 + m * 16;
                const float rs = rsv[ai][m];
                float sq = 0.f;
#pragma unroll
                for (int bj = 0; bj < 2; ++bj) {
                    f32x4 v0 = acc[ai][bj][m][0] * rs, v1 = acc[ai][bj][m][1] * rs;
                    const int cl = bj * 128 + wc * 32 + 8 * fq;
                    if (kind == 3) {
                        float* o = PRW + (size_t)row * PRW_LD + (pn - 17) * 256 + cl;
                        *(f32x4*)o = v0; *(f32x4*)(o + 4) = v1;
                    } else {
                        if (ssq) sq += (v0[0] * v0[0] + v0[1] * v0[1]) + (v0[2] * v0[2] + v0[3] * v0[3]) + (v1[0] * v1[0] + v1[1] * v1[1]) + (v1[2] * v1[2] + v1[3] * v1[3]);
                        if (kind == 1) {
#pragma unroll
                            for (int e = 0; e < 4; ++e) { v0[e] = fsilu(v0[e]); v1[e] = fsilu(v1[e]); }
                        } else if (kind == 2) {
#pragma unroll
                            for (int e = 0; e < 4; ++e) { v0[e] = fsigmoid(v0[e]); v1[e] = fsigmoid(v1[e]); }
                        }
                        u32x4 w; w.x = cvtpk(v0[0], v0[1]); w.y = cvtpk(v0[2], v0[3]); w.z = cvtpk(v1[0], v1[1]); w.w = cvtpk(v1[2], v1[3]);
                        *(u32x4*)(P + (size_t)row * NP + pn * 256 + cl) = w;
                    }
                }
                if (ssq) { sq += __shfl_xor(sq, 16); sq += __shfl_xor(sq, 32); if (fq == 0) atomicAdd(ssq + row, sq); }
            }
    }
};

struct EpiB {
    static constexpr bool HAS_MID = false;
    bf16_t* Qf; bf16_t* Kf; bf16_t* Vf; const bf16_t* P; const float* ssq_cq; const float* ssq_ckv; const float* ssq_kr;
    const float* qn_g; const float* kn_g; const float* rope; LAS float* scr;
    __device__ __forceinline__ void operator()(const f32x4 (&acc)[2][2][4][2], const GUnit& u, int wr, int wc, int fr, int fq) const {
        const int h = u.pn; const bool isq = (u.aux == 0);
        const float* ssqA = isq ? ssq_cq : ssq_ckv;
        LAS float* part = scr; LAS float* rstdL = scr + 1024;
        const int row0 = u.pm * 256 + wr * 64 + fr;
        float sv[2][4], krv[2][4];
#pragma unroll
        for (int ai = 0; ai < 2; ++ai)
#pragma unroll
            for (int m = 0; m < 4; ++m) { const int row = row0 + ai * 128 + m * 16; sv[ai][m] = ssqA[row]; krv[ai][m] = isq ? 0.f : ssq_kr[row]; }
#pragma unroll
        for (int ai = 0; ai < 2; ++ai)
#pragma unroll
            for (int m = 0; m < 4; ++m) sv[ai][m] = rsqrtf(sv[ai][m] * (1.f / 512.f) + EPS);
#pragma unroll
        for (int ai = 0; ai < 2; ++ai)
#pragma unroll
            for (int m = 0; m < 4; ++m) {
                const float s = sv[ai][m];
                float sq = 0.f;
#pragma unroll
                for (int bj = 0; bj < 2; ++bj) {
                    if (!isq && bj == 1) continue;
                    const f32x4 v0 = acc[ai][bj][m][0] * s, v1 = acc[ai][bj][m][1] * s;
                    sq += (v0[0] * v0[0] + v0[1] * v0[1]) + (v0[2] * v0[2] + v0[3] * v0[3]) + (v1[0] * v1[0] + v1[1] * v1[1]) + (v1[2] * v1[2] + v1[3] * v1[3]);
                }
                sq += __shfl_xor(sq, 16); sq += __shfl_xor(sq, 32);
                if (fq == 0) part[(ai * 128 + wr * 64 + m * 16 + fr) * 4 + wc] = sq;
                __builtin_amdgcn_sched_barrier(0);
            }
        LDS_WAIT(); PG8_BAR;
        const float* gq = isq ? qn_g : kn_g;
        const int c0 = wc * 32 + 8 * fq;
        f32x4 g0 = *(const f32x4*)(gq + c0), g1 = *(const f32x4*)(gq + c0 + 4);
        const int j = 4 * wc + fq;
        f32x4 gr1 = (f32x4){0.f, 0.f, 0.f, 0.f}, gr2 = gr1;
        if (isq && wc < 2) { gr1 = *(const f32x4*)(qn_g + 128 + 4 * j); gr2 = *(const f32x4*)(qn_g + 160 + 4 * j); }
#pragma unroll
        for (int ai = 0; ai < 2; ++ai)
#pragma unroll
            for (int m = 0; m < 4; ++m) {
                const int rl = ai * 128 + wr * 64 + m * 16 + fr, row = u.pm * 256 + rl;
                const f32x4 pp = *(const LAS f32x4*)(part + rl * 4);
                float tot = (pp[0] + pp[1]) + (pp[2] + pp[3]);
                if (!isq) tot += krv[ai][m];
                const float rstd = rsqrtf(tot * (1.f / 192.f) + EPS);
                const float s = sv[ai][m];
                if (isq) {
                    const float f = s * rstd * CQ_MLA;
                    { const f32x4 v0 = acc[ai][0][m][0] * f * g0, v1 = acc[ai][0][m][1] * f * g1;
                      u32x4 w; w.x = cvtpk(v0[0], v0[1]); w.y = cvtpk(v0[2], v0[3]); w.z = cvtpk(v1[0], v1[1]); w.w = cvtpk(v1[2], v1[3]);
                      *(u32x4*)(Qf + (size_t)row * 1536 + h * 192 + c0) = w; }
                    if (wc < 2) {
                        const int pos = row & (S - 1);
                        const f32x4 cs = *(const f32x4*)(rope + pos * 32 + 4 * j), sn = *(const f32x4*)(rope + S * 32 + pos * 32 + 4 * j);
                        const f32x4 x1 = acc[ai][1][m][0] * f * gr1, x2 = acc[ai][1][m][1] * f * gr2;
                        const f32x4 y1 = x1 * cs - x2 * sn, y2 = x1 * sn + x2 * cs;
                        u32x4 w; w.x = cvtpk(y1[0], y1[1]); w.y = cvtpk(y1[2], y1[3]); w.z = cvtpk(y2[0], y2[1]); w.w = cvtpk(y2[2], y2[3]);
                        *(u32x4*)(Qf + (size_t)row * 1536 + h * 192 + 128 + 8 * j) = w;
                    }
                } else {
                    if (wc == 0 && fq == 0) rstdL[rl] = rstd;
                    const float f = s * rstd;
                    { const f32x4 v0 = acc[ai][0][m][0] * f * g0, v1 = acc[ai][0][m][1] * f * g1;
                      u32x4 w; w.x = cvtpk(v0[0], v0[1]); w.y = cvtpk(v0[2], v0[3]); w.z = cvtpk(v1[0], v1[1]); w.w = cvtpk(v1[2], v1[3]);
                      *(u32x4*)(Kf + (size_t)row * 1536 + h * 192 + c0) = w; }
                    { const f32x4 v0 = acc[ai][1][m][0] * s, v1 = acc[ai][1][m][1] * s;
                      u32x4 w; w.x = cvtpk(v0[0], v0[1]); w.y = cvtpk(v0[2], v0[3]); w.z = cvtpk(v1[0], v1[1]); w.w = cvtpk(v1[2], v1[3]);
                      *(u32x4*)(Vf + (size_t)row * 1024 + h * 128 + c0) = w; }
                }
                __builtin_amdgcn_sched_barrier(0);
            }
        if (!isq) {
            LDS_WAIT(); PG8_BAR;
            int tid = fr + 16 * fq + 64 * (wr * 4 + wc);
            const int rl = tid >> 1, jj0 = (tid & 1) * 4, row = u.pm * 256 + rl, pos = row & (S - 1);
            const float rstd = rstdL[rl];
            const bf16_t* kr = P + (size_t)row * NP + PC_KR;
            u32x2 av[4], bv[4]; f32x4 csv[4], snv[4];
#pragma unroll
            for (int jj = 0; jj < 4; ++jj) { const int j2 = jj0 + jj; av[jj] = *(const u32x2*)(kr + 4 * j2); bv[jj] = *(const u32x2*)(kr + 32 + 4 * j2);
                csv[jj] = *(const f32x4*)(rope + pos * 32 + 4 * j2); snv[jj] = *(const f32x4*)(rope + S * 32 + pos * 32 + 4 * j2); }
#pragma unroll
            for (int jj = 0; jj < 4; ++jj) {
                const int j2 = jj0 + jj;
                const u32x2 a = av[jj], b = bv[jj];
                const f32x4 ga = *(const f32x4*)(kn_g + 128 + 4 * j2), gb = *(const f32x4*)(kn_g + 160 + 4 * j2);
                const f32x4 cs = csv[jj], sn = snv[jj];
                const f32x4 x1 = (f32x4){bflo(a.x), bfhi(a.x), bflo(a.y), bfhi(a.y)} * rstd * ga, x2 = (f32x4){bflo(b.x), bfhi(b.x), bflo(b.y), bfhi(b.y)} * rstd * gb;
                const f32x4 y1 = x1 * cs - x2 * sn, y2 = x1 * sn + x2 * cs;
                u32x4 w; w.x = cvtpk(y1[0], y1[1]); w.y = cvtpk(y1[2], y1[3]); w.z = cvtpk(y2[0], y2[1]); w.w = cvtpk(y2[2], y2[3]);
                *(u32x4*)(Kf + (size_t)row * 1536 + h * 192 + 128 + 8 * j2) = w;
            }
        }
    }
};

struct EpiD {
    static constexpr bool HAS_MID = true;
    static constexpr float GMIN = 1e-5f;
    bf16_t* Mb; const bf16_t* P;
    __device__ __forceinline__ void mid(f32x4 (&acc)[2][2][4][2], const GUnit& u, int t, int wr, int wc, int fr, int fq) const {
        const int from = (t == 8) ? 0 : 1; const int row0 = u.pm * 256 + wr * 64 + fr;
        const int col0 = u.pn * 256 + wc * 32 + 8 * fq;
#pragma unroll
        for (int ai = 0; ai < 2; ++ai) {
            u32x4 ga[4][2], gb[4][2];
#pragma unroll
            for (int m = 0; m < 4; ++m)
#pragma unroll
                for (int bj = 0; bj < 2; ++bj) {
                    const bf16_t* gp = P + (size_t)(row0 + ai * 128 + m * 16) * NP + PC_GATE + from * 2048 + col0 + bj * 128;
                    ga[m][bj] = *(const u32x4*)gp; gb[m][bj] = *(const u32x4*)(gp + 2048);
                }
#pragma unroll
            for (int m = 0; m < 4; ++m)
#pragma unroll
                for (int bj = 0; bj < 2; ++bj) {
                    const u32x4 a_ = ga[m][bj], b_ = gb[m][bj];
                    f32x4 r0, r1;
                    r0[0] = fmaxf(bflo(a_.x), GMIN) * __builtin_amdgcn_rcpf(fmaxf(bflo(b_.x), GMIN)); r0[1] = fmaxf(bfhi(a_.x), GMIN) * __builtin_amdgcn_rcpf(fmaxf(bfhi(b_.x), GMIN));
                    r0[2] = fmaxf(bflo(a_.y), GMIN) * __builtin_amdgcn_rcpf(fmaxf(bflo(b_.y), GMIN)); r0[3] = fmaxf(bfhi(a_.y), GMIN) * __builtin_amdgcn_rcpf(fmaxf(bfhi(b_.y), GMIN));
                    r1[0] = fmaxf(bflo(a_.z), GMIN) * __builtin_amdgcn_rcpf(fmaxf(bflo(b_.z), GMIN)); r1[1] = fmaxf(bfhi(a_.z), GMIN) * __builtin_amdgcn_rcpf(fmaxf(bfhi(b_.z), GMIN));
                    r1[2] = fmaxf(bflo(a_.w), GMIN) * __builtin_amdgcn_rcpf(fmaxf(bflo(b_.w), GMIN)); r1[3] = fmaxf(bfhi(a_.w), GMIN) * __builtin_amdgcn_rcpf(fmaxf(bfhi(b_.w), GMIN));
                    acc[ai][bj][m][0] *= r0; acc[ai][bj][m][1] *= r1;
                }
            __builtin_amdgcn_sched_barrier(0);
        }
    }
    __device__ __forceinline__ void operator()(const f32x4 (&acc)[2][2][4][2], const GUnit& u, int wr, int wc, int fr, int fq) const {
        const int row0 = u.pm * 256 + wr * 64 + fr;
#pragma unroll
        for (int ai = 0; ai < 2; ++ai) {
            u32x4 gv[4][2];
#pragma unroll
            for (int m = 0; m < 4; ++m)
#pragma unroll
                for (int bj = 0; bj < 2; ++bj) gv[m][bj] = *(const u32x4*)(P + (size_t)(row0 + ai * 128 + m * 16) * NP + PC_GATE + 2 * 2048 + u.pn * 256 + bj * 128 + wc * 32 + 8 * fq);
#pragma unroll
            for (int m = 0; m < 4; ++m) {
                const int row = row0 + ai * 128 + m * 16;
#pragma unroll
                for (int bj = 0; bj < 2; ++bj) {
                    const int col = u.pn * 256 + bj * 128 + wc * 32 + 8 * fq;
                    const u32x4 g = gv[m][bj];
                    const f32x4 v0 = acc[ai][bj][m][0] * (f32x4){fmaxf(bflo(g.x), GMIN), fmaxf(bfhi(g.x), GMIN), fmaxf(bflo(g.y), GMIN), fmaxf(bfhi(g.y), GMIN)};
                    const f32x4 v1 = acc[ai][bj][m][1] * (f32x4){fmaxf(bflo(g.z), GMIN), fmaxf(bfhi(g.z), GMIN), fmaxf(bflo(g.w), GMIN), fmaxf(bfhi(g.w), GMIN)};
                    u32x4 w; w.x = cvtpk(v0[0], v0[1]); w.y = cvtpk(v0[2], v0[3]); w.z = cvtpk(v1[0], v1[1]); w.w = cvtpk(v1[2], v1[3]);
                    *(u32x4*)(Mb + (size_t)row * DM + col) = w;
                }
            }
        }
    }
};

struct EpiE {
    static constexpr bool HAS_MID = false;
    const float* xin; float* xout; bf16_t* xb; float* ssq; bool dry;
    __device__ __forceinline__ void operator()(const f32x4 (&acc)[2][2][4][2], const GUnit& u, int wr, int wc, int fr, int fq) const {
        const int row0 = u.pm * 256 + wr * 64 + fr;
#pragma unroll
        for (int ai = 0; ai < 2; ++ai)
#pragma unroll
            for (int m = 0; m < 4; ++m) {
                const int row = row0 + ai * 128 + m * 16; float sq = 0.f;
#pragma unroll
                for (int bj = 0; bj < 2; ++bj) {
                    const int col = u.pn * 256 + bj * 128 + wc * 32 + 8 * fq;
                    const float* xp = xin + (size_t)row * DM + col;
                    const f32x4 v0 = acc[ai][bj][m][0] + *(const f32x4*)xp, v1 = acc[ai][bj][m][1] + *(const f32x4*)(xp + 4);
                    float* op = xout + (size_t)row * DM + col;
                    *(f32x4*)op = v0; *(f32x4*)(op + 4) = v1;
                    if (ssq) {
                        sq += (v0[0] * v0[0] + v0[1] * v0[1]) + (v0[2] * v0[2] + v0[3] * v0[3]) + (v1[0] * v1[0] + v1[1] * v1[1]) + (v1[2] * v1[2] + v1[3] * v1[3]);
                        u32x4 w; w.x = cvtpk(v0[0], v0[1]); w.y = cvtpk(v0[2], v0[3]); w.z = cvtpk(v1[0], v1[1]); w.w = cvtpk(v1[2], v1[3]);
                        *(u32x4*)(xb + (size_t)row * DM + col) = w;
                    }
                }
                if (ssq && !dry) { sq += __shfl_xor(sq, 16); sq += __shfl_xor(sq, 32); if (fq == 0) atomicAdd(ssq + row, sq); }
            }
    }
};

__device__ __forceinline__ int tr_srcmap(int kind, int n);
__device__ __forceinline__ void transpose_one(const float* W, int ldw, int Ndst, bf16_t* WT, int ldd, int kofs, const float* kscale, int kind,
                                              LAS float* scr, int it, int lane) {
    const int nblk = Ndst / 32;
    const int kb = it / nblk, nb = it % nblk, k0 = 64 * kb, n0 = 32 * nb;
    const int sc = tr_srcmap(kind, n0 + (lane & 31));
    float tv[32];
    const float* wp = W + (size_t)(k0 + (lane >> 5)) * ldw + (sc >= 0 ? sc : 0);
#pragma unroll
    for (int i = 0; i < 32; ++i) tv[i] = __builtin_nontemporal_load(wp + (size_t)(2 * i) * ldw);
    if (kscale) {
#pragma unroll
        for (int i = 0; i < 32; ++i) tv[i] *= kscale[k0 + 2 * i + (lane >> 5)];
    }
#pragma unroll
    for (int i = 0; i < 32; ++i) scr[(2 * i + (lane >> 5)) * 33 + (lane & 31)] = (sc >= 0) ? tv[i] : 0.f;
    LDS_WAIT(); asm volatile("" ::: "memory");
    const int c = lane & 7;
#pragma unroll
    for (int j = 0; j < 4; ++j) { const int n = (lane >> 3) + 8 * j; const LAS float* s = scr + (8 * c) * 33 + n;
        u32x4 o; o.x = pk2(s[0 * 33], s[1 * 33]); o.y = pk2(s[2 * 33], s[3 * 33]); o.z = pk2(s[4 * 33], s[5 * 33]); o.w = pk2(s[6 * 33], s[7 * 33]);
        *(u32x4*)(WT + (size_t)(n0 + n) * ldd + kofs + k0 + 8 * c) = o; }
    LDS_WAIT(); asm volatile("" ::: "memory");
}
struct MapId { __device__ __forceinline__ int operator()(int n) const { return n; } };
struct MapIn { __device__ __forceinline__ int operator()(int n) const {
    if (n < 3072) return n;
    if (n < 3328) return (n - 3072 < 64) ? n : -1;
    if (n < 4352) return n - 3328 + 3136;
    if (n < 5888) return n - 4352 + 4160;
    if (n < 6144) return (n - 5888 < 128) ? 5696 + (n - 5888) : -1;
    if (n < 6656) return n - 6144 + 5824;
    return n - 6656 + 6336; } };
struct MapUq { __device__ __forceinline__ int operator()(int n) const {
    const int h = n >> 8, p = n & 255;
    if (p < 128) return h * 192 + p;
    if (p < 192) { const int j = (p - 128) >> 3, e = (p - 128) & 7; return h * 192 + 128 + (e >> 2) * 32 + 4 * j + (e & 3); }
    return -1; } };

__device__ __forceinline__ int tr_srcmap(int kind, int n) { return kind == 1 ? MapIn()(n) : (kind == 2 ? MapUq()(n) : n); }

__device__ __forceinline__ void sincos_acc(float ang, float& sn, float& cs) {
    const double x = (double)ang;
    const double rev = x * 0.15915494309189535;
    const double fr = rev - __builtin_rint(rev);
    const double r = fr * 6.283185307179586476925;
    const double r2 = r * r;
    double ts = 1.0, ss = 1.0, tc = 1.0, sc2 = 1.0;
#pragma unroll
    for (int k = 1; k <= 13; ++k) { tc = -tc * r2 * (1.0 / (double)((2 * k - 1) * (2 * k))); sc2 += tc; ts = -ts * r2 * (1.0 / (double)((2 * k) * (2 * k + 1))); ss += ts; }
    sn = (float)(r * ss); cs = (float)sc2;
}

__device__ __forceinline__ int crow(int r, int hi) { return (r & 3) + 8 * (r >> 2) + 4 * hi; }
__device__ __forceinline__ int v_st(int k, int c) { const int kk = (k & ~0xC) | ((k & 4) << 1) | ((k & 8) >> 1); return ((kk >> 3) * 4 + (c >> 5)) * 512 + ((kk & 7) * 32 + (c & 31)) * 2; }
__device__ __forceinline__ int v_rd_base(int lane) { return ((lane & 3) << 3) | (((lane >> 2) & 3) << 6) | (((lane >> 4) & 1) << 5) | (((lane >> 5) & 1) << 8); }
constexpr int v_rd_off(int d0, int ks, int half) { return d0 * 512 + ks * 4096 + half * 2048; }
template <int OFF> __device__ __forceinline__ s16x4 tr_read(int vb) {
    s16x4 r; asm volatile("ds_read_b64_tr_b16 %0, %1 offset:%2" : "=&v"(r) : "v"(vb), "i"(OFF) : "memory"); return r;
}
template <int D0> __device__ __forceinline__ void pv_one(f32x16& od, int vb, bf16x8 pa0, bf16x8 pa1, bf16x8 pa2, bf16x8 pa3) {
    const s16x4 l0 = tr_read<v_rd_off(D0, 0, 0)>(vb), h0 = tr_read<v_rd_off(D0, 0, 1)>(vb), l1 = tr_read<v_rd_off(D0, 1, 0)>(vb), h1 = tr_read<v_rd_off(D0, 1, 1)>(vb);
    const s16x4 l2 = tr_read<v_rd_off(D0, 2, 0)>(vb), h2 = tr_read<v_rd_off(D0, 2, 1)>(vb), l3 = tr_read<v_rd_off(D0, 3, 0)>(vb), h3 = tr_read<v_rd_off(D0, 3, 1)>(vb);
    asm volatile("s_waitcnt lgkmcnt(0)" ::: "memory"); __builtin_amdgcn_sched_barrier(0);
#define PK(L, H) (bf16x8){L[0], L[1], L[2], L[3], H[0], H[1], H[2], H[3]}
    od = __builtin_amdgcn_mfma_f32_32x32x16_bf16(pa0, PK(l0, h0), od, 0, 0, 0);
    od = __builtin_amdgcn_mfma_f32_32x32x16_bf16(pa1, PK(l1, h1), od, 0, 0, 0);
    od = __builtin_amdgcn_mfma_f32_32x32x16_bf16(pa2, PK(l2, h2), od, 0, 0, 0);
    od = __builtin_amdgcn_mfma_f32_32x32x16_bf16(pa3, PK(l3, h3), od, 0, 0, 0);
#undef PK
}
#define PK4(P, BASE, OUT) do { unsigned a0 = cvtpk(P[BASE + 0], P[BASE + 1]), a1 = cvtpk(P[BASE + 2], P[BASE + 3]);   \
    unsigned b0 = cvtpk(P[BASE + 4], P[BASE + 5]), b1 = cvtpk(P[BASE + 6], P[BASE + 7]);                              \
    auto r0 = __builtin_amdgcn_permlane32_swap(a0, b0, false, false); auto r1 = __builtin_amdgcn_permlane32_swap(a1, b1, false, false); \
    u32x4 w_ = {r0[0], r1[0], r0[1], r1[1]}; OUT = __builtin_bit_cast(bf16x8, w_); } while (0)

__device__ __forceinline__ void sb_block(f32x16& Z, int keyb, int rowi, int hi, float R, float& E) {
#pragma unroll
    for (int g = 3; g >= 0; --g) {
        float lf[4], zz[4]; bool vd[4];
#pragma unroll
        for (int q = 0; q < 4; ++q) {
            const float z = Z[4 * g + q] * SCALE_SB; const bool valid = (keyb + 8 * g + q) < rowi;
            const float sp = fmaxf(z, 0.f) + __logf(1.f + __expf(-fabsf(z)));
            lf[q] = valid ? -sp : 0.f; zz[q] = z; vd[q] = valid;
        }
        const float ex3 = 0.f, ex2 = lf[3], ex1 = ex2 + lf[2], ex0 = ex1 + lf[1], G = ex0 + lf[0];
        const float Gp = __shfl_xor(G, 32);
        const float off = R + E + (hi == 0 ? Gp : 0.f);
        Z[4 * g + 0] = vd[0] ? __expf(zz[0] + lf[0] + off + ex0) : 0.f;
        Z[4 * g + 1] = vd[1] ? __expf(zz[1] + lf[1] + off + ex1) : 0.f;
        Z[4 * g + 2] = vd[2] ? __expf(zz[2] + lf[2] + off + ex2) : 0.f;
        Z[4 * g + 3] = vd[3] ? __expf(zz[3] + lf[3] + off + ex3) : 0.f;
        E += G + Gp;
    }
}

template <int DQK, bool SBM>
__device__ __forceinline__ void attn_unit(LAS unsigned char* lds, const bf16_t* Qp, int ldq, const bf16_t* Kp, int ldk, const bf16_t* Vp, int ldv,
                                          const bf16_t* Gp, int ldg, bf16_t* Op, int ldo, int qb) {
    constexpr int KROW = DQK * 2, KT_BYTES = 64 * KROW, VT_BYTES = 64 * 128 * 2, NKP = DQK / 64, ND0 = DQK / 16, PPR = DQK / 8;
    int tid = threadIdx.x; asm volatile("" : "+v"(tid));
    const int wid = __builtin_amdgcn_readfirstlane(tid >> 6), lane = tid & 63, r32 = lane & 31, hi = lane >> 5;
    LAS unsigned char* Kl = lds; LAS unsigned char* Vl = lds + 3 * KT_BYTES;
    LAS float* wscr = (LAS float*)(lds + LDS_SCR + 9216) + wid * 64;
    LAS int* flags = (LAS int*)(lds + LDS_SCR + 11264);
    bf16x8 qr[ND0];
    { const bf16_t* Qw = Qp + (size_t)(wid * 32 + r32) * ldq + hi * 8;
#pragma unroll
      for (int d0 = 0; d0 < ND0; ++d0) qr[d0] = *(const bf16x8*)(Qw + d0 * 16); }
    f32x16 o[4];
#pragma unroll
    for (int d = 0; d < 4; ++d)
#pragma unroll
        for (int r = 0; r < 16; ++r) o[d][r] = 0.f;
    float m_reg = -1e30f, l_reg = 0.f, R = 0.f;
    const int NT = 4 * qb + 4;
    const int vb0 = (int)(uintptr_t)Vl + v_rd_base(lane);
    int koff[NKP], voff[2];
#pragma unroll
    for (int i = 0; i < NKP; ++i) { const int q = (wid * NKP + i) * 64 + lane, row = q / PPR, c16 = q % PPR; koff[i] = row * ldk + ((c16 ^ (row & 7)) * 8); }
#pragma unroll
    for (int i = 0; i < 2; ++i) { const int q = (wid * 2 + i) * 64 + lane, st = q >> 5, wi = q & 31, kk = (st >> 2) * 8 + (wi >> 2), c = (st & 3) * 32 + (wi & 3) * 8;
        const int k = (kk & ~0xC) | ((kk & 4) << 1) | ((kk & 8) >> 1); voff[i] = k * ldv + c; }
#define ISSUE(kt, b) do { _Pragma("unroll") for (int i = 0; i < NKP; ++i) __builtin_amdgcn_global_load_lds((const unsigned*)(Kp + (size_t)(kt) * 64 * ldk + koff[i]), \
            (LAS unsigned*)(Kl + (b) * KT_BYTES + (wid * NKP + i) * 1024), 16, 0, 0); \
        _Pragma("unroll") for (int i = 0; i < 2; ++i) __builtin_amdgcn_global_load_lds((const unsigned*)(Vp + (size_t)(kt) * 64 * ldv + voff[i]), \
            (LAS unsigned*)(Vl + (b) * VT_BYTES + (wid * 2 + i) * 1024), 16, 0, 0); } while (0)
    ISSUE(SBM ? NT - 1 : 0, 0);
    if (NT > 1) { ISSUE(SBM ? NT - 2 : 1, 1); if constexpr (NKP == 3) asm volatile("s_waitcnt vmcnt(5)" ::: "memory"); else asm volatile("s_waitcnt vmcnt(4)" ::: "memory"); }
    else asm volatile("s_waitcnt vmcnt(0)" ::: "memory");
    __syncthreads();
    const int rowi = 256 * qb + 32 * wid + r32;
    for (int it = 0; it < NT; ++it) {
        const int kt = SBM ? NT - 1 - it : it, buf = it % 3;
        if (it + 2 < NT) ISSUE(SBM ? kt - 2 : kt + 2, (it + 2) % 3);
        const bool active = SBM ? (64 * kt <= 256 * qb + 32 * wid + 30) : (kt <= 4 * qb + (wid >> 1));
        if (active) {
            f32x16 p0, p1;
#pragma unroll
            for (int r = 0; r < 16; ++r) { p0[r] = 0.f; p1[r] = 0.f; }
            LAS unsigned char* Kb = Kl + buf * KT_BYTES;
#pragma unroll
            for (int dl = 0; dl < 4; ++dl) {
                LAS unsigned char* kb_dl = Kb + r32 * KROW + ((dl * 32 + hi * 16) ^ ((r32 & 7) << 4));
#pragma unroll
                for (int dh = 0; dh < ND0 / 4; ++dh) {
                    const bf16x8 b0 = *(const LAS bf16x8*)(kb_dl + dh * 128);
                    const bf16x8 b1 = *(const LAS bf16x8*)(kb_dl + dh * 128 + 32 * KROW);
                    p0 = __builtin_amdgcn_mfma_f32_32x32x16_bf16(b0, qr[4 * dh + dl], p0, 0, 0, 0);
                    p1 = __builtin_amdgcn_mfma_f32_32x32x16_bf16(b1, qr[4 * dh + dl], p1, 0, 0, 0); }
                __builtin_amdgcn_sched_barrier(0); }
            if constexpr (SBM) {
                float E = 0.f;
                sb_block(p1, kt * 64 + 32 + 4 * hi, rowi, hi, R, E);
                sb_block(p0, kt * 64 + 4 * hi, rowi, hi, R, E);
                R += E;
            } else {
                float pmax = p0[0];
#pragma unroll
                for (int r = 1; r < 16; ++r) pmax = fmaxf(pmax, p0[r]);
#pragma unroll
                for (int r = 0; r < 16; ++r) pmax = fmaxf(pmax, p1[r]);
                pmax = fmaxf(pmax, __shfl_xor(pmax, 32));
                float mn = m_reg, alpha = 1.f;
                if (!__all(pmax - m_reg <= 8.f)) { mn = fmaxf(m_reg, pmax); alpha = __builtin_amdgcn_exp2f(m_reg - mn); m_reg = mn; }
                float ps = 0.f;
#pragma unroll
                for (int r = 0; r < 16; ++r) { p0[r] = __builtin_amdgcn_exp2f(p0[r] - mn); ps += p0[r]; }
#pragma unroll
                for (int r = 0; r < 16; ++r) { p1[r] = __builtin_amdgcn_exp2f(p1[r] - mn); ps += p1[r]; }
                ps += __shfl_xor(ps, 32);
                l_reg = l_reg * alpha + ps;
                if (__any(alpha < 1.f)) {
                    if (hi == 0) wscr[r32] = alpha;
                    LDS_WAIT();
#pragma unroll
                    for (int r = 0; r < 16; ++r) { const float al = wscr[crow(r, hi)];
#pragma unroll
                        for (int d = 0; d < 4; ++d) o[d][r] *= al; }
                }
            }
            bf16x8 pa0, pa1, pa2, pa3;
            PK4(p0, 0, pa0); PK4(p0, 8, pa1); PK4(p1, 0, pa2); PK4(p1, 8, pa3);
            const int vb = vb0 + buf * VT_BYTES;
            pv_one<0>(o[0], vb, pa0, pa1, pa2, pa3); pv_one<1>(o[1], vb, pa0, pa1, pa2, pa3); pv_one<2>(o[2], vb, pa0, pa1, pa2, pa3); pv_one<3>(o[3], vb, pa0, pa1, pa2, pa3);
        }
        if constexpr (SBM) { const int dn = __all(R < -104.f) ? 1 : 0; if (lane == 0) flags[(it & 1) * 8 + wid] = dn; }
        if (it + 2 < NT) { if constexpr (NKP == 3) asm volatile("s_waitcnt vmcnt(5)" ::: "memory"); else asm volatile("s_waitcnt vmcnt(4)" ::: "memory"); }
        else asm volatile("s_waitcnt vmcnt(0)" ::: "memory");
        __syncthreads();
        if constexpr (SBM) {
            int alld = 1;
#pragma unroll
            for (int w = 0; w < 8; ++w) alld &= flags[(it & 1) * 8 + w];
            if (alld) { asm volatile("s_waitcnt vmcnt(0)" ::: "memory"); break; }
        }
    }
    if constexpr (SBM) __syncthreads();
    if constexpr (!SBM) { if (hi == 0) wscr[r32] = l_reg; LDS_WAIT(); }
    LAS float* ot = (LAS float*)lds + wid * (32 * 132);
#pragma unroll
    for (int r = 0; r < 16; ++r) { const int orow = crow(r, hi);
        float rl = 1.f; if constexpr (!SBM) rl = __builtin_amdgcn_rcpf(wscr[orow]);
#pragma unroll
        for (int d0 = 0; d0 < 4; ++d0) ot[orow * 132 + d0 * 32 + r32] = o[d0][r] * rl; }
    LDS_WAIT();
    { const int er = lane >> 4, ec = (lane & 15) * 8;
      const bf16_t* Gw = Gp + (size_t)(wid * 32 + er) * ldg + ec; bf16_t* Ow = Op + (size_t)(wid * 32 + er) * ldo + ec;
      u32x4 gv[8];
#pragma unroll
      for (int ps = 0; ps < 8; ++ps) gv[ps] = *(const u32x4*)(Gw + (size_t)(ps * 4) * ldg);
#pragma unroll
      for (int ps = 0; ps < 8; ++ps) {
          const f32x4 a0 = *(const LAS f32x4*)(ot + (ps * 4 + er) * 132 + ec), a1 = *(const LAS f32x4*)(ot + (ps * 4 + er) * 132 + ec + 4);
          const u32x4 g = gv[ps];
          u32x4 w; w.x = cvtpk(a0[0] * bflo(g.x), a0[1] * bfhi(g.x)); w.y = cvtpk(a0[2] * bflo(g.y), a0[3] * bfhi(g.y));
          w.z = cvtpk(a1[0] * bflo(g.z), a1[1] * bfhi(g.z)); w.w = cvtpk(a1[2] * bflo(g.w), a1[3] * bfhi(g.w));
          *(u32x4*)(Ow + (size_t)(ps * 4) * ldo) = w;
          __builtin_amdgcn_sched_barrier(0);
      } }
    __syncthreads();
#undef ISSUE
}

__device__ __forceinline__ float rowsum16(float x) {
    x += __builtin_bit_cast(float, __builtin_amdgcn_update_dpp(0, __builtin_bit_cast(int, x), 0x128, 0xf, 0xf, false));
    x += __builtin_bit_cast(float, __builtin_amdgcn_update_dpp(0, __builtin_bit_cast(int, x), 0x124, 0xf, 0xf, false));
    x += __builtin_bit_cast(float, __builtin_amdgcn_update_dpp(0, __builtin_bit_cast(int, x), 0x122, 0xf, 0xf, false));
    x += __builtin_bit_cast(float, __builtin_amdgcn_update_dpp(0, __builtin_bit_cast(int, x), 0x121, 0xf, 0xf, false));
    return x;
}

__device__ __forceinline__ float wsum64(float x) {
    x = rowsum16(x);
    const int xi = __builtin_bit_cast(int, x);
    const float r0 = __builtin_bit_cast(float, __builtin_amdgcn_readlane(xi, 0)), r1 = __builtin_bit_cast(float, __builtin_amdgcn_readlane(xi, 16));
    const float r2 = __builtin_bit_cast(float, __builtin_amdgcn_readlane(xi, 32)), r3 = __builtin_bit_cast(float, __builtin_amdgcn_readlane(xi, 48));
    return (r0 + r1) + (r2 + r3);
}

template <int NB>
__device__ __forceinline__ void rw_finaliseN(int it0, int stride, const float* gng, const float* gnb, const float* rk, const float* OSC, const float* SCN, const bf16_t* P, bf16_t* ycat) {
    int tl = threadIdx.x; asm volatile("" : "+v"(tl)); const int lane = tl & 63;
    float ov[NB], rr[NB], kk_[NB], vv_[NB], gg[NB];
#pragma unroll
    for (int q = 0; q < NB; ++q) { const int it = it0 + q * stride, t = it >> 3, h = it & 7, b = t >> 12, s = t & (S - 1), ch = h * 64 + lane;
        ov[q] = OSC[(size_t)t * 512 + ch];
        const float* sp = SCN + ((size_t)(b * 8 + h) * S + s) * 384 + lane;
        rr[q] = sp[0]; kk_[q] = sp[128]; vv_[q] = sp[320];
        gg[q] = bf2f(P[(size_t)t * NP + PC_RG + ch]); }
#pragma unroll
    for (int q = 0; q < NB; ++q) { const int it = it0 + q * stride, t = it >> 3, h = it & 7, ch = h * 64 + lane;
        const float mu = wsum64(ov[q]) * (1.f / 64.f), d = ov[q] - mu, var = wsum64(d * d) * (1.f / 64.f);
        const float y = d * rsqrtf(var + 64e-5f) * gng[ch] + gnb[ch];
        const float bonus = wsum64(rr[q] * kk_[q] * rk[ch]) * vv_[q];
        ycat[(size_t)t * DM + 1536 + ch] = (bf16_t)f2bf((y + bonus) * gg[q]); }
}

struct RwParams { const float* PRW; const float* mu; const float* w0; const float* w_up; const float* a0; const float* a_up; const float* k_k; const float* k_a; float* SCN; };

__device__ __forceinline__ void rw_prep(LAS unsigned char* lds, const RwParams& q, int tile) {
    int tid = threadIdx.x; asm volatile("" : "+v"(tid));
    const int lane = tid & 63, h = tid >> 6, t0 = tile * 32;
    LAS float* tw = (LAS float*)lds; LAS float* ta = tw + 2048;
#pragma unroll
    for (int e = 0; e < 8; ++e) { const int idx = tid + 512 * e, tk = idx >> 7, jj = idx & 127, t = t0 + tk;
        const float cur = q.PRW[(size_t)t * PRW_LD + 1536 + jj];
        const float prev = ((t & (S - 1)) == 0) ? 0.f : q.PRW[(size_t)(t - 1) * PRW_LD + 1536 + jj];
        const float sh = cur + q.mu[1536 + jj] * (prev - cur);
        if (jj < 64) tw[tk * 64 + jj] = tanhf(sh); else ta[tk * 64 + jj - 64] = sh; }
    __syncthreads();
    float aw[32], aa[32];
#pragma unroll
    for (int k = 0; k < 32; ++k) { aw[k] = 0.f; aa[k] = 0.f; }
    for (int j0 = 0; j0 < 64; j0 += 4) {
        float wu[4], au[4];
#pragma unroll
        for (int e = 0; e < 4; ++e) { wu[e] = q.w_up[(j0 + e) * 512 + tid]; au[e] = q.a_up[(j0 + e) * 512 + tid]; }
#pragma unroll
        for (int k = 0; k < 32; ++k) { const f32x4 x = *(const LAS f32x4*)(tw + k * 64 + j0), y = *(const LAS f32x4*)(ta + k * 64 + j0);
            aw[k] += (x[0] * wu[0] + x[1] * wu[1]) + (x[2] * wu[2] + x[3] * wu[3]);
            aa[k] += (y[0] * au[0] + y[1] * au[1]) + (y[2] * au[2] + y[3] * au[3]); }
    }
    const float w0c = q.w0[tid], a0c = q.a0[tid], kkc = q.k_k[tid], kac = q.k_a[tid], mur = q.mu[tid], muk = q.mu[512 + tid], muv = q.mu[1024 + tid];
    float pr = 0.f, pk = 0.f, pv = 0.f;
    if ((t0 & (S - 1)) != 0) { const float* pp = q.PRW + (size_t)(t0 - 1) * PRW_LD; pr = pp[tid]; pk = pp[512 + tid]; pv = pp[1024 + tid]; }
    const int b = t0 >> 12, s0 = t0 & (S - 1);
    float* dst = q.SCN + ((size_t)(b * 8 + h) * S + s0) * 384 + lane;
#pragma unroll
    for (int k = 0; k < 32; ++k) {
        const float* cp = q.PRW + (size_t)(t0 + k) * PRW_LD;
        const float cr = cp[tid], ck = cp[512 + tid], cv = cp[1024 + tid];
        const float rs_ = cr + mur * (pr - cr), ks_ = ck + muk * (pk - ck), vs_ = cv + muv * (pv - cv);
        pr = cr; pk = ck; pv = cv;
        const float uu = -(w0c + aw[k]);
        const float spl = fmaxf(uu, 0.f) + log1pf(expf(-fabsf(uu)));
        const float decay = expf(-expf(-spl - 0.5f));
        const float a = 1.f / (1.f + expf(-(a0c + aa[k])));
        float kk = ks_ * kkc; const float n2 = wsum64(kk * kk); kk = kk / fmaxf(sqrtf(n2), 1e-12f);
        const float kmod = ks_ * (1.f + (a - 1.f) * kac);
        float* d = dst + (size_t)k * 384;
        d[0] = rs_; d[64] = decay; d[128] = kmod; d[192] = -kk; d[256] = kk * a; d[320] = vs_;
    }
    __syncthreads();
}

__device__ __forceinline__ void rw_prep_mfma(LAS unsigned char* lds, const RwParams& q, int tile) {
    int tid = threadIdx.x; asm volatile("" : "+v"(tid));
    const int lane = tid & 63, h = __builtin_amdgcn_readfirstlane(tid >> 6), t0 = tile * 32, l16 = lane & 15, lq = lane >> 4;
    constexpr int TS = 65;
    LAS float* tw = (LAS float*)lds; LAS float* ta = tw + 32 * TS;
#pragma unroll
    for (int e = 0; e < 8; ++e) { const int idx = tid + 512 * e, tk = idx >> 7, jj = idx & 127, t = t0 + tk;
        const float cur = q.PRW[(size_t)t * PRW_LD + 1536 + jj];
        const float prev = ((t & (S - 1)) == 0) ? 0.f : q.PRW[(size_t)(t - 1) * PRW_LD + 1536 + jj];
        const float sh = cur + q.mu[1536 + jj] * (prev - cur);
        if (jj < 64) { const float e2 = __expf(-2.f * fabsf(sh)), th = (1.f - e2) * __builtin_amdgcn_rcpf(1.f + e2); tw[tk * TS + jj] = sh < 0.f ? -th : th; }
        else ta[tk * TS + jj - 64] = sh; }
    __syncthreads();
    f32x4 accW[2][4], accA[2][4];
#pragma unroll
    for (int tb = 0; tb < 2; ++tb)
#pragma unroll
        for (int cb = 0; cb < 4; ++cb) { accW[tb][cb] = (f32x4){0.f, 0.f, 0.f, 0.f}; accA[tb][cb] = (f32x4){0.f, 0.f, 0.f, 0.f}; }
    const float* wu = q.w_up + h * 64 + l16; const float* au = q.a_up + h * 64 + l16;
#pragma unroll 2
    for (int ks = 0; ks < 16; ++ks) {
        const int kk = 4 * ks + lq;
        float aW[2], aA[2], bW[4], bA[4];
#pragma unroll
        for (int tb = 0; tb < 2; ++tb) { aW[tb] = tw[(tb * 16 + l16) * TS + kk]; aA[tb] = ta[(tb * 16 + l16) * TS + kk]; }
#pragma unroll
        for (int cb = 0; cb < 4; ++cb) { bW[cb] = wu[kk * 512 + cb * 16]; bA[cb] = au[kk * 512 + cb * 16]; }
#pragma unroll
        for (int tb = 0; tb < 2; ++tb)
#pragma unroll
            for (int cb = 0; cb < 4; ++cb) { accW[tb][cb] = __builtin_amdgcn_mfma_f32_16x16x4f32(aW[tb], bW[cb], accW[tb][cb], 0, 0, 0);
                                             accA[tb][cb] = __builtin_amdgcn_mfma_f32_16x16x4f32(aA[tb], bA[cb], accA[tb][cb], 0, 0, 0); }
    }
    const int b = t0 >> 12, s0 = t0 & (S - 1);
#pragma unroll
    for (int tb = 0; tb < 2; ++tb) {
        const int tkb = tb * 16 + 4 * lq;
        const bool first = (((t0 + tkb) & (S - 1)) == 0);
        float kkv[4][4], av[4][4];
#pragma unroll
        for (int cb = 0; cb < 4; ++cb) {
            const int c = h * 64 + cb * 16 + l16;
            const float w0c = q.w0[c], a0c = q.a0[c], kkc = q.k_k[c], kac = q.k_a[c], mur = q.mu[c], muk = q.mu[512 + c], muv = q.mu[1024 + c];
            float pr = 0.f, pk = 0.f, pv = 0.f;
            if (!first) { const float* pp = q.PRW + (size_t)(t0 + tkb - 1) * PRW_LD; pr = pp[c]; pk = pp[512 + c]; pv = pp[1024 + c]; }
#pragma unroll
            for (int r = 0; r < 4; ++r) {
                const float* cp = q.PRW + (size_t)(t0 + tkb + r) * PRW_LD;
                const float cr = cp[c], ck = cp[512 + c], cv = cp[1024 + c];
                const float rs_ = cr + mur * (pr - cr), ks_ = ck + muk * (pk - ck), vs_ = cv + muv * (pv - cv);
                pr = cr; pk = ck; pv = cv;
                const float uu = -(w0c + accW[tb][cb][r]);
                const float spl = fmaxf(uu, 0.f) + __logf(1.f + __expf(-fabsf(uu)));
                const float decay = __expf(-__expf(-spl - 0.5f));
                const float a = __builtin_amdgcn_rcpf(1.f + __expf(-(a0c + accA[tb][cb][r])));
                kkv[cb][r] = ks_ * kkc; av[cb][r] = a;
                float* d = q.SCN + ((size_t)(b * 8 + h) * S + s0 + tkb + r) * 384 + cb * 16 + l16;
                d[0] = rs_; d[64] = decay; d[128] = ks_ * (1.f + (a - 1.f) * kac); d[320] = vs_;
            }
        }
#pragma unroll
        for (int r = 0; r < 4; ++r) {
            float n2 = (kkv[0][r] * kkv[0][r] + kkv[1][r] * kkv[1][r]) + (kkv[2][r] * kkv[2][r] + kkv[3][r] * kkv[3][r]);
            n2 = rowsum16(n2);
            const float inv = __builtin_amdgcn_rsqf(fmaxf(n2, 1e-24f));
            float* d = q.SCN + ((size_t)(b * 8 + h) * S + s0 + tkb + r) * 384 + l16;
#pragma unroll
            for (int cb = 0; cb < 4; ++cb) { const float kn = kkv[cb][r] * inv; d[192 + cb * 16] = -kn; d[256 + cb * 16] = kn * av[cb][r]; }
        }
    }
    __syncthreads();
}

__device__ __forceinline__ void rw_scan(LAS unsigned char* lds, const float* SCN, float* OSC, int sb) {
    int tid = threadIdx.x; asm volatile("" : "+v"(tid));
    const int wid = __builtin_amdgcn_readfirstlane(tid >> 6), lane = tid & 63;
    const int bh = sb >> 2, rg = sb & 3, b = bh >> 3, h = bh & 7;
    const float* src = SCN + (size_t)bh * S * 384;
    constexpr int CH = 16, CHF = CH * 384, NCH = S / CH;
    LAS float* bufs = (LAS float*)lds;
    LAS float* pb = bufs + 4 * CHF;
    const int rowl = 4 * wid + (lane >> 4), cg4 = (lane & 15) * 4;
    f32x4 s = (f32x4){0.f, 0.f, 0.f, 0.f};
#define SCAN_ISSUE(ch) do { const float* sp_ = src + (size_t)(ch) * CHF + lane * 4; LAS float* dp_ = bufs + ((ch) & 3) * CHF; \
        _Pragma("unroll") for (int i = 0; i < 12; ++i) { const int j = (wid - 4) * 12 + i; \
            __builtin_amdgcn_global_load_lds((const unsigned*)(sp_ + j * 256), (LAS unsigned*)(dp_ + j * 256), 16, 0, 0); } } while (0)
    if (wid == 4 || wid == 5) { SCAN_ISSUE(0); SCAN_ISSUE(1); SCAN_ISSUE(2); asm volatile("s_waitcnt vmcnt(24)" ::: "memory"); }
    __syncthreads();
    for (int c = 0; c < NCH; ++c) {
        if (wid < 4) {
            const LAS float* bp = bufs + (c & 3) * CHF + cg4;
            const LAS float* vp = bufs + (c & 3) * CHF + 320 + 16 * rg + rowl;
            LAS float* pp = pb + (c & 1) * 4096 + wid * 64 + lane;
            f32x4 r4[3], w4[3], k4[3], a4[3], b4[3]; float vv[3];
            const unsigned ba = (unsigned)(uintptr_t)bp, va = (unsigned)(uintptr_t)vp;
#define LRD128(dst, addr, off) asm volatile("ds_read_b128 %0, %1 offset:%2" : "=v"(dst) : "v"(addr), "i"(off))
#define LRD32(dst, addr, off) asm volatile("ds_read_b32 %0, %1 offset:%2" : "=v"(dst) : "v"(addr), "i"(off))
#define RD_STEP(set, stp) do { LRD128(r4[set], ba, (stp) * 1536); LRD128(w4[set], ba, (stp) * 1536 + 256); LRD128(k4[set], ba, (stp) * 1536 + 512); \
        LRD128(a4[set], ba, (stp) * 1536 + 768); LRD128(b4[set], ba, (stp) * 1536 + 1024); LRD32(vv[set], va, (stp) * 1536); } while (0)
#define WAITK(n, set) asm volatile("s_waitcnt lgkmcnt(" #n ")" : "+v"(r4[set]), "+v"(w4[set]), "+v"(k4[set]), "+v"(a4[set]), "+v"(b4[set]), "+v"(vv[set]))
#define STEP_BODY(st, cu) do { const f32x4 sa4 = s * a4[cu]; float sa = (sa4[0] + sa4[1]) + (sa4[2] + sa4[3]); \
        const f32x4 t1 = s * w4[cu] + vv[cu] * k4[cu]; sa = rowsum16(sa); s = t1 + sa * b4[cu]; \
        const f32x4 o4 = s * r4[cu]; pp[(st) * 256] = (o4[0] + o4[1]) + (o4[2] + o4[3]); } while (0)
#define STEP(st) do { RD_STEP(((st) + 2) % 3, (st) + 2); WAITK(12, (st) % 3); STEP_BODY(st, (st) % 3); } while (0)
            RD_STEP(0, 0); RD_STEP(1, 1);
            STEP(0); STEP(1); STEP(2); STEP(3); STEP(4); STEP(5); STEP(6); STEP(7); STEP(8); STEP(9); STEP(10); STEP(11); STEP(12); STEP(13);
            WAITK(6, 14 % 3); STEP_BODY(14, 14 % 3);
            WAITK(0, 15 % 3); STEP_BODY(15, 15 % 3);
#undef STEP
#undef STEP_BODY
#undef WAITK
#undef RD_STEP
#undef LRD32
#undef LRD128
        } else if (wid < 6) {
            if (c + 3 < NCH) { SCAN_ISSUE(c + 3); asm volatile("s_waitcnt vmcnt(24)" ::: "memory"); }
            else if (c + 2 < NCH) asm volatile("s_waitcnt vmcnt(12)" ::: "memory");
            else asm volatile("s_waitcnt vmcnt(0)" ::: "memory");
        } else if (c > 0) {
            const int lt = tid - 384;
#pragma unroll
            for (int e = 0; e < 2; ++e) { const int oi = lt * 2 + e, st = oi >> 4, rl = oi & 15;
                const LAS f32x4* p4 = (const LAS f32x4*)(pb + ((c - 1) & 1) * 4096 + oi * 16);
                const f32x4 x0 = p4[0], x1 = p4[1], x2 = p4[2], x3 = p4[3];
                const f32x4 t = (x0 + x1) + (x2 + x3);
                OSC[((size_t)b * S + (c - 1) * CH + st) * 512 + h * 64 + 16 * rg + rl] = (t[0] + t[1]) + (t[2] + t[3]); }
        }
        asm volatile("s_waitcnt lgkmcnt(0)" ::: "memory"); __builtin_amdgcn_s_barrier(); asm volatile("" ::: "memory");
    }
    if (wid >= 6) { const int lt = tid - 384;
#pragma unroll
        for (int e = 0; e < 2; ++e) { const int oi = lt * 2 + e, st = oi >> 4, rl = oi & 15;
            const LAS f32x4* p4 = (const LAS f32x4*)(pb + ((NCH - 1) & 1) * 4096 + oi * 16);
            const f32x4 x0 = p4[0], x1 = p4[1], x2 = p4[2], x3 = p4[3];
            const f32x4 t = (x0 + x1) + (x2 + x3);
            OSC[((size_t)b * S + (NCH - 1) * CH + st) * 512 + h * 64 + 16 * rg + rl] = (t[0] + t[1]) + (t[2] + t[3]); } }
    __syncthreads();
#undef SCAN_ISSUE
}

#ifndef PHMASK
#define PHMASK 127
#endif
#ifndef DUPMASK
#define DUPMASK 0
#endif

struct Args { const float* in[23]; float* out; unsigned char* ws; int ph_lo, ph_hi; };

__global__ void __launch_bounds__(512) fwd(Args a) {
    extern __shared__ __attribute__((aligned(16))) unsigned char lds_raw[];
    LAS unsigned char* lds = (LAS unsigned char*)lds_raw;
    cg::grid_group grid = cg::this_grid();
    const int tid = threadIdx.x, lane = tid & 63, wave = __builtin_amdgcn_readfirstlane(tid >> 6);
    const int G = gridDim.x, bx = blockIdx.x, vc = vblock(bx, G);
    const int gw = bx * 8 + wave, ngw = G * 8;
    unsigned char* ws = a.ws;
    float* ctl = (float*)(ws + WS_CTL);
    float* rope = (float*)(ws + WS_ROPE);
    bf16_t* xb = (bf16_t*)(ws + WS_XB); bf16_t* P = (bf16_t*)(ws + WS_P); float* PRW = (float*)(ws + WS_PRW);
    bf16_t* Qf = (bf16_t*)(ws + WS_QF); bf16_t* Kf = (bf16_t*)(ws + WS_KF); bf16_t* Vf = (bf16_t*)(ws + WS_VF);
    float* SCN = (float*)(ws + WS_SCN); float* OSC = (float*)(ws + WS_OSC); bf16_t* ycat = (bf16_t*)(ws + WS_YCAT);
    float* M32 = (float*)(ws + WS_MRG32); bf16_t* Mb = (bf16_t*)(ws + WS_MRGB);
    const float* x_in = a.in[0];
    int ph = 0;
#define PH_ON() (ph >= a.ph_lo && ph < a.ph_hi)
    volatile LAS unsigned* xb_st = (volatile LAS unsigned*)(lds + LDS_BYTES - 16);
    if (tid < 4) xb_st[tid] = 0u;
    __syncthreads();
    XcdBarrier xbar = xcd_barrier_post((unsigned*)(ws + WS_CTL) + CTL_QUEUE + 32768, xb_st);
#define GBAR() xcd_barrier(xbar)
    if (a.ph_lo < 0) grid.sync();
#define SEAM() do { if (ph + 1 > a.ph_lo && ph + 1 < a.ph_hi) { GBAR(); } ++ph; } while (0)

    for (int rep = 0; rep < (((DUPMASK) & 1) ? 2 : 1); ++rep) { if (rep) GBAR(); if (PH_ON() && (PHMASK & 1)) {
        LAS float* scr = (LAS float*)(lds + wave * 8704);
        {
            constexpr int I_IN = 32 * 400, I_UQ = 8 * 64, I_UKV = 8 * 64, I_SB = 8 * 64, I_MLA = 16 * 64, I_RW = 8 * 64, I_OUT = 32 * 64;
            constexpr int I_LAYER = I_IN + I_UQ + I_UKV + I_SB + I_MLA + I_RW + I_OUT;
            for (int it = gw; it < 2 * I_LAYER; it += ngw) {
                const int l = it >= I_LAYER; int r = it - l * I_LAYER;
                bf16_t* wbr = (bf16_t*)(ws + WS_WBR) + (size_t)l * DM * DM;
                if (r < I_IN) { transpose_one(a.in[2] + (size_t)l * DM * 12480, 12480, NP, (bf16_t*)(ws + WS_WIN) + (size_t)l * NP * DM, DM, 0, a.in[1] + l * DM, 1, scr, r, lane); continue; } r -= I_IN;
                if (r < I_OUT) { transpose_one(a.in[22] + (size_t)l * DM * DM, DM, DM, (bf16_t*)(ws + WS_WOUT) + (size_t)l * DM * DM, DM, 0, nullptr, 0, scr, r, lane); continue; } r -= I_OUT;
                if (r < I_MLA) { transpose_one(a.in[20] + (size_t)l * 1024 * DM, DM, DM, wbr, DM, 512, nullptr, 0, scr, r, lane); continue; } r -= I_MLA;
                if (r < I_UQ) { transpose_one(a.in[5] + (size_t)l * 512 * 1536, 1536, 2048, (bf16_t*)(ws + WS_WUQ) + (size_t)l * 2048 * 512, 512, 0, a.in[3] + l * 512, 2, scr, r, lane); continue; } r -= I_UQ;
                if (r < I_UKV) { transpose_one(a.in[6] + (size_t)l * 512 * 2048, 2048, 2048, (bf16_t*)(ws + WS_WUKV) + (size_t)l * 2048 * 512, 512, 0, a.in[4] + l * 512, 0, scr, r, lane); continue; } r -= I_UKV;
                if (r < I_SB) { transpose_one(a.in[19] + (size_t)l * 512 * DM, DM, DM, wbr, DM, 0, nullptr, 0, scr, r, lane); continue; } r -= I_SB;
                transpose_one(a.in[21] + (size_t)l * 512 * DM, DM, DM, wbr, DM, 1536, nullptr, 0, scr, r, lane);
            }
        }
        for (int m = gw; m < T; m += ngw) {
            const f32x4* xr = (const f32x4*)(x_in + (size_t)m * DM) + lane; float sq = 0.f;
            u32x2* o8 = (u32x2*)(xb + (size_t)m * DM) + lane;
#pragma unroll
            for (int j = 0; j < 8; ++j) { const f32x4 v = __builtin_nontemporal_load(xr + 64 * j); sq += (v[0] * v[0] + v[1] * v[1]) + (v[2] * v[2] + v[3] * v[3]);
                u32x2 w; w.x = pk2(v[0], v[1]); w.y = pk2(v[2], v[3]); o8[64 * j] = w; }
            sq = wave_sum(sq);
            if (lane == 0) ctl[CTL_SSQX + m] = sq;
        }
        for (int e = bx * 512 + tid; e < S * 32; e += G * 512) {
            const int pos = e >> 5, i = e & 31;
            double f = 1.0; for (int k = 0; k < i; ++k) f *= 0.7498942093324559;
            const float ff = (float)f, ang = (float)pos * ff;
            float sn, cs; sincos_acc(ang, sn, cs);
            rope[e] = cs; rope[S * 32 + e] = sn;
        }
    } }
    SEAM();

    for (int l = 0; l < 2; ++l) {
        float* ssqx = ctl + CTL_SSQX + l * T; float* ssq_cq = ctl + CTL_SSQCQ + l * T; float* ssq_ckv = ctl + CTL_SSQCKV + l * T; float* ssq_kr = ctl + CTL_SSQKR + l * T;
        if (PH_ON()) {
            SchedA1 Sd{(const char*)xb, (const char*)((bf16_t*)(ws + WS_WIN) + (size_t)l * NP * DM), G, vc, (G == 256) ? 32 : 0};
            EpiA E{P, PRW, ssqx, ssq_cq, ssq_ckv, ssq_kr};
            pg8::gemm_phase(lds, DM, DM, Sd, E);
        }
        SEAM();
        if (PH_ON()) {
            RwParams rp{PRW, a.in[9] + l * 1664, a.in[10] + l * 512, a.in[11] + (size_t)l * 64 * 512, a.in[12] + l * 512, a.in[13] + (size_t)l * 64 * 512,
                        a.in[14] + l * 512, a.in[15] + l * 512, SCN};
            for (int tile = bx; tile < 256; tile += G) rw_prep_mfma(lds, rp, tile);
        }
        SEAM();
        for (int rep = 0; rep < 1; ++rep) { if (PH_ON()) {
            const int nscan = (G == 256) ? 64 : 0;
            constexpr int A2_MAIN = 43 * 32 - 32;
            unsigned* sbar = (unsigned*)(ws + WS_CTL) + CTL_QUEUE + 2048;
            const unsigned nsub = (unsigned)(G - nscan);
            if (bx < nscan) {
                rw_scan(lds, SCN, OSC, ((bx & 15) << 2) | (bx >> 4));
                {
                    const int bh = bx & 15, rgq = bx >> 4, hb = bh >> 3, hh = bh & 7;
                    grid_bar((unsigned*)(ws + WS_CTL) + CTL_QUEUE + 4096 + 64 * bh, 4u * (unsigned)(l + 1));
                    if (tid == 0) { while (__hip_atomic_load(sbar, __ATOMIC_RELAXED, __HIP_MEMORY_SCOPE_AGENT) < nsub * (unsigned)(2 * l + 1)) __builtin_amdgcn_s_sleep(8);
                                    __builtin_amdgcn_fence(__ATOMIC_ACQUIRE, "agent"); asm volatile("s_waitcnt vmcnt(0)" ::: "memory"); }
                    __syncthreads();
                    {
                        int tl = threadIdx.x; asm volatile("" : "+v"(tl)); const int ln = tl & 63, ch = hh * 64 + ln;
                        const float gng_c = a.in[17][l * 512 + ch], gnb_c = a.in[18][l * 512 + ch], rk_c = a.in[16][l * 512 + ch];
                        const size_t tq0 = (size_t)hb * S + 1024 * rgq;
                        const float* osc_b = OSC + tq0 * 512 + ch; const float* scn_b = SCN + ((size_t)bh * S + 1024 * rgq) * 384 + ln;
                        const bf16_t* g_b = P + tq0 * NP + PC_RG + ch; bf16_t* y_b = ycat + tq0 * DM + 1536 + ch;
                        float ov0[8], rr0[8], kk0[8], vv0[8], gg0[8], ov1[8], rr1[8], kk1[8], vv1[8], gg1[8];
#define FIN_LOAD(OV, RR, KK, VV, GG, tok) do { _Pragma("unroll") for (int q = 0; q < 8; ++q) { const size_t t_ = (size_t)((tok) + q); \
        OV[q] = osc_b[t_ * 512]; RR[q] = scn_b[t_ * 384]; KK[q] = scn_b[t_ * 384 + 128]; VV[q] = scn_b[t_ * 384 + 320]; GG[q] = bf2f(g_b[t_ * NP]); } } while (0)
#define FIN_COMP(OV, RR, KK, VV, GG, tok) do { _Pragma("unroll") for (int q = 0; q < 8; ++q) { \
        const float mu = wsum64(OV[q]) * (1.f / 64.f), d = OV[q] - mu, var = wsum64(d * d) * (1.f / 64.f); \
        const float y = d * __builtin_amdgcn_rsqf(var + 64e-5f) * gng_c + gnb_c; \
        const float bonus = wsum64(RR[q] * KK[q] * rk_c) * VV[q]; \
        y_b[(size_t)((tok) + q) * DM] = (bf16_t)(cvtpk((y + bonus) * GG[q], 0.f) & 0xffffu); } } while (0)
                        FIN_LOAD(ov0, rr0, kk0, vv0, gg0, wave * 8);
                        for (int i8 = wave * 8; i8 < 1024; i8 += 128) {
                            FIN_LOAD(ov1, rr1, kk1, vv1, gg1, i8 + 64);
                            FIN_COMP(ov0, rr0, kk0, vv0, gg0, i8);
                            if (i8 + 128 < 1024) FIN_LOAD(ov0, rr0, kk0, vv0, gg0, i8 + 128);
                            FIN_COMP(ov1, rr1, kk1, vv1, gg1, i8 + 64);
                        }
#undef FIN_LOAD
#undef FIN_COMP
                    }
                }
                if (tid == 0) { while (__hip_atomic_load(sbar, __ATOMIC_RELAXED, __HIP_MEMORY_SCOPE_AGENT) < nsub * (unsigned)(2 * l + 2)) __builtin_amdgcn_s_sleep(8);
                                __builtin_amdgcn_fence(__ATOMIC_ACQUIRE, "agent"); asm volatile("s_waitcnt vmcnt(0)" ::: "memory"); }
                __syncthreads();
            } else {
                if (nscan == 0) { for (int sb = bx; sb < 64; sb += G) rw_scan(lds, SCN, OSC, sb); }
                {   SchedA2 Sd{(const char*)xb, (const char*)((bf16_t*)(ws + WS_WIN) + (size_t)l * NP * DM), bx - nscan, G - nscan, nscan ? A2_MAIN : 43 * 32};
                    EpiA E{P, PRW, ssqx, ssq_cq, ssq_ckv, ssq_kr};
                    pg8::gemm_phase(lds, DM, DM, Sd, E); }
                grid_bar(sbar, nsub * (unsigned)(2 * l + 1));
                {   SchedB Sd{(const char*)P, (const char*)((bf16_t*)(ws + WS_WUQ) + (size_t)l * 2048 * 512), (const char*)((bf16_t*)(ws + WS_WUKV) + (size_t)l * 2048 * 512), G - nscan, vblock(bx - nscan, G - nscan)};
                    EpiB E{Qf, Kf, Vf, P, ssq_cq, ssq_ckv, ssq_kr, a.in[7] + l * 192, a.in[8] + l * 192, rope, (LAS float*)(lds + LDS_SCR)};
                    pg8::gemm_phase(lds, NP, 512, Sd, E); }
                grid_bar(sbar, nsub * (unsigned)(2 * l + 2));
            }
            unsigned* queue = (unsigned*)(ws + WS_CTL) + CTL_QUEUE + l * 64 + rep * 32;
            LAS unsigned* ubox = (LAS unsigned*)(lds + LDS_SCR + 8192);
            for (;;) {
#if defined(DUPC_SCANONLY)
                if (rep) break;
#endif
                if (tid == 0) *ubox = atomicAdd(queue, 1u);
                __syncthreads();
                const unsigned u = *ubox;
                __syncthreads();
                if (u >= 384u) break;
                if (u < 256u) {
                    const int qb = 15 - (int)(u >> 4), bh = u & 15, b = bh >> 3, h = bh & 7;
                    const size_t t0 = (size_t)b * S + qb * 256, tb = (size_t)b * S;
#ifndef NO_MLA
                    attn_unit<192, false>(lds, Qf + t0 * 1536 + h * 192, 1536, Kf + tb * 1536 + h * 192, 1536, Vf + tb * 1024 + h * 128, 1024,
                                          P + t0 * NP + PC_MG + h * 128, NP, ycat + t0 * DM + 512 + h * 128, DM, qb);
#endif
                } else {
                    const unsigned u2 = u - 256u; const int qb = 15 - (int)(u2 >> 3), bh = u2 & 7, b = bh >> 2, h = bh & 3;
                    const size_t t0 = (size_t)b * S + qb * 256, tb = (size_t)b * S;
#ifndef NO_SB
                    attn_unit<128, true>(lds, P + t0 * NP + PC_SBQ + h * 128, NP, P + tb * NP + PC_SBK + h * 128, NP, P + tb * NP + PC_SBV + h * 128, NP,
                                         P + t0 * NP + PC_SBG + h * 128, NP, ycat + t0 * DM + h * 128, DM, qb);
#endif
                }
            }
        } }
        SEAM();
        if (PH_ON()) {
            if (G != 256) { for (int it0 = gw * 4; it0 < T * 8; it0 += ngw * 4) rw_finaliseN<4>(it0, 1, a.in[17] + l * 512, a.in[18] + l * 512, a.in[16] + l * 512, OSC, SCN, P, ycat); }
        }
        if (G != 256) { SEAM(); } else { ++ph; }
        for (int rep = 0; rep < (((DUPMASK) & 32) ? 2 : 1); ++rep) { if (rep) GBAR(); if (PH_ON() && (PHMASK & 32)) {
            SchedD Sd{(const char*)ycat, (const char*)((bf16_t*)(ws + WS_WBR) + (size_t)l * DM * DM), G, vc};
            EpiD E{Mb, P};
            pg8::gemm_phase(lds, DM, DM, Sd, E);
        } }
        SEAM();
        for (int rep = 0; rep < (((DUPMASK) & 64) ? 2 : 1); ++rep) { if (rep) GBAR(); if (PH_ON() && (PHMASK & 64)) {
            SchedE Sd{(const char*)Mb, (const char*)((bf16_t*)(ws + WS_WOUT) + (size_t)l * DM * DM), G, vc};
            if (rep && l == 1) break;
            EpiE E{l == 0 ? x_in : a.out, a.out, xb, l == 0 ? (ctl + CTL_SSQX + T) : nullptr, rep != 0};
            pg8::gemm_phase(lds, DM, DM, Sd, E);
        } }
        SEAM();
    }
}

#ifndef MK_MULTI
#define MK_MULTI 0
#endif
extern "C" void kernel_launch(void* const* d_in, const int* in_sizes, int n_in, void* d_out, int out_size, void* d_ws, size_t ws_size, hipStream_t stream) {
    static int grid = 0;
    if (grid == 0) {
        if (n_in != 23 || out_size != T * DM || ws_size < WS_END) { fprintf(stderr, "kernel_launch: unexpected shapes (n_in %d out %d ws %zu)\n", n_in, out_size, ws_size); grid = -1; return; }
        int dev = 0, cus = 0, per_cu = 0;
        (void)hipGetDevice(&dev);
        (void)hipDeviceGetAttribute(&cus, hipDeviceAttributeMultiprocessorCount, dev);
        (void)hipFuncSetAttribute((const void*)fwd, hipFuncAttributeMaxDynamicSharedMemorySize, LDS_BYTES);
        (void)hipOccupancyMaxActiveBlocksPerMultiprocessor(&per_cu, (const void*)fwd, 512, LDS_BYTES);
        if (per_cu < 1) per_cu = 1;
        grid = cus * per_cu;
    }
    if (grid < 0) return;
    (void)hipMemsetAsync((char*)d_ws + WS_CTL, 0, 1 * MiB, stream);
    Args a{};
    for (int i = 0; i < 23; ++i) a.in[i] = (const float*)d_in[i];
    a.out = (float*)d_out; a.ws = (unsigned char*)d_ws;
#if MK_MULTI
    for (int p = 0; p < 13; ++p) { a.ph_lo = p; a.ph_hi = p + 1; hipLaunchKernelGGL(fwd, dim3(grid), dim3(512), LDS_BYTES, stream, a); }
#else
    a.ph_lo = 0; a.ph_hi = 13;
    void* args[] = {&a};
    hipError_t e = hipLaunchCooperativeKernel((const void*)fwd, dim3(grid), dim3(512), args, LDS_BYTES, stream);
    if (e != hipSuccess) fprintf(stderr, "cooperative launch failed: %s (grid %d)\n", hipGetErrorString(e), grid);
#endif
}
```
